# Optimizing an MI355X kernel written in HIP

```python
import jax, jax.numpy as jnp
from jax import lax
import numpy as np

D_MODEL = 1024
BATCH = 16
SEQ = 2048
DEPTH = 4
DEC_BATCH = 8
DEC_SEQ = 16
PAST_LEN = 4096

CHUNK = 64
GMLP_CHUNK = 128
Q_BLOCK = 128
G_A = 4
DG_A = 64
W_A = G_A * DG_A
H_B = 4
NOPE_DIM = 128
ROPE_DIM = 64
V_DIM = 128
W_B = H_B * V_DIM
Q_LORA = 384
KV_LORA = 256
ROPE_THETA = 10000.0
MLA_SCALE = (NOPE_DIM + ROPE_DIM) ** -0.5
H_C = 4
D_C = 64
W_C = H_C * D_C
SB_SCALE = D_C ** -0.5
MIX_WIDTH = W_A + W_B + W_C
W_IN_COLS = 2 * W_A + Q_LORA + KV_LORA + ROPE_DIM + 3 * W_C
D_FF = 4 * D_MODEL
ALPHA = (2 * DEPTH) ** 0.25
BETA = (8 * DEPTH) ** -0.25
EPS = 1e-5

kernel_name = 'hybrid_gmlp_mla_stickbreak_stream_step'


def in_split_points():
    sizes = (W_A, W_A, Q_LORA, KV_LORA, ROPE_DIM, W_C, W_C)
    return [int(v) for v in np.cumsum(sizes)]


def layer_norm(x, g=None, b=None):
    xf = x.astype(jnp.float32)
    mu = xf.mean(-1, keepdims=True)
    var = jnp.square(xf - mu).mean(-1, keepdims=True)
    y = (xf - mu) * lax.rsqrt(var + EPS)
    if g is not None:
        y = y * g.astype(jnp.float32) + b.astype(jnp.float32)
    return y.astype(x.dtype)


def rms_norm(x, g):
    xf = x.astype(jnp.float32)
    y = xf * lax.rsqrt(jnp.mean(jnp.square(xf), -1, keepdims=True) + EPS) * g.astype(jnp.float32)
    return y.astype(x.dtype)


def rope(x, pos):
    half = ROPE_DIM // 2
    inv = ROPE_THETA ** (-jnp.arange(half, dtype=jnp.float32) / half)
    ang = pos.astype(jnp.float32)[:, None] * inv[None, :]
    shape = (1, pos.shape[0]) + (1,) * (x.ndim - 3) + (half,)
    cos = jnp.cos(ang).reshape(shape)
    sin = jnp.sin(ang).reshape(shape)
    xf = x.astype(jnp.float32)
    x1, x2 = xf[..., :half], xf[..., half:]
    return jnp.concatenate([x1 * cos - x2 * sin, x2 * cos + x1 * sin], -1).astype(x.dtype)


def chunk_visible(q_pos, k_pos):
    return (k_pos // CHUNK)[None, :] <= (q_pos // CHUNK)[:, None]


def spatial_gate(u, v, w_s, b_s):
    b, s = u.shape[:2]
    c = min(s, GMLP_CHUNK)
    n_c = s // c
    idx = jnp.arange(c)
    w = jnp.where(chunk_visible(idx, idx)[None], w_s[:, :c, :c], 0)
    vc = v.reshape(b, n_c, c, G_A, DG_A)
    mixed = jnp.einsum('gij,bnjgd->bnigd', w, vc) + b_s[:, :c].T[None, None, :, :, None]
    return u * mixed.reshape(b, s, G_A, DG_A)


def mla_attend(q_pos, q_lat, q_rope, ckv, krope, k_pos):
    scores = (jnp.einsum('bqhc,bkc->bhqk', q_lat, ckv)
              + jnp.einsum('bqhr,bkr->bhqk', q_rope, krope)).astype(jnp.float32) * MLA_SCALE
    scores = jnp.where(chunk_visible(q_pos, k_pos)[None, None], scores, -jnp.inf)
    p = jax.nn.softmax(scores, axis=-1).astype(ckv.dtype)
    return jnp.einsum('bhqk,bkc->bqhc', p, ckv)


def sb_attend(q_pos, q, k, v, k_pos):
    z = jnp.einsum('bqhd,bkhd->bhqk', q, k).astype(jnp.float32) * SB_SCALE
    mask = (k_pos[None, :] < q_pos[:, None])[None, None]
    log_skip = jnp.where(mask, jax.nn.log_sigmoid(-z), 0.0)
    suffix = lax.cumsum(log_skip, axis=3, reverse=True) - log_skip
    w = jnp.where(mask, jnp.exp(jax.nn.log_sigmoid(z) + suffix), 0.0)
    return jnp.einsum('bhqk,bkhd->bqhd', w.astype(v.dtype), v)


def sweep_query_blocks(attend, q_pos, *q_args):
    nq = q_pos.shape[0]
    if nq <= Q_BLOCK:
        return attend(q_pos, *q_args)
    nb = nq // Q_BLOCK
    blocked = tuple(jnp.moveaxis(a.reshape((a.shape[0], nb, Q_BLOCK) + a.shape[2:]), 1, 0) for a in q_args)
    out = lax.map(lambda xs: attend(xs[0], *xs[1]), (q_pos.reshape(nb, Q_BLOCK), blocked))
    out = jnp.moveaxis(out, 0, 1)
    return out.reshape((out.shape[0], nq) + out.shape[3:])


def trunk_layer(x, q_pos, past, w_in, w_s, b_s, g_cq, g_ckv, w_uq, w_uk, w_uv, g_mix, w_out,
                ln1_g, ln1_b, w_up, b_up, w_down, b_down, ln2_g, ln2_b):
    b, s, _ = x.shape
    p = x @ w_in
    a_u, a_v, b_cq, b_ckv, b_kr, c_q, c_k, c_v = jnp.split(p, in_split_points(), axis=-1)

    u = jax.nn.gelu(a_u).reshape(b, s, G_A, DG_A)
    v = layer_norm(jax.nn.gelu(a_v).reshape(b, s, G_A, DG_A))
    y_a = spatial_gate(u, v, w_s, b_s).reshape(b, s, W_A)

    q = jnp.einsum('bsc,chd->bshd', rms_norm(b_cq, g_cq), w_uq)
    q_rope = rope(q[..., NOPE_DIM:], q_pos)
    q_lat = jnp.einsum('bshn,hcn->bshc', q[..., :NOPE_DIM], w_uk)
    ckv = rms_norm(b_ckv, g_ckv)
    krope = rope(b_kr, q_pos)

    qc = c_q.reshape(b, s, H_C, D_C)
    kc = c_k.reshape(b, s, H_C, D_C)
    vc = c_v.reshape(b, s, H_C, D_C)

    if past is None:
        ckv_all, kr_all, k_all, v_all, k_pos = ckv, krope, kc, vc, q_pos
    else:
        ckv_p, kr_p, k_p, v_p = past
        ckv_all = jnp.concatenate([ckv_p, ckv], 1)
        kr_all = jnp.concatenate([kr_p, krope], 1)
        k_all = jnp.concatenate([k_p, kc], 1)
        v_all = jnp.concatenate([v_p, vc], 1)
        k_pos = jnp.concatenate([jnp.arange(ckv_p.shape[1], dtype=jnp.int32), q_pos])

    out_lat = sweep_query_blocks(lambda qp, ql, qr: mla_attend(qp, ql, qr, ckv_all, kr_all, k_pos),
                                 q_pos, q_lat, q_rope)
    y_b = jnp.einsum('bshc,hcd->bshd', out_lat, w_uv).reshape(b, s, W_B)
    y_c = sweep_query_blocks(lambda qp, qq: sb_attend(qp, qq, k_all, v_all, k_pos),
                             q_pos, qc).reshape(b, s, W_C)

    g_a, g_b, g_c = jnp.split(g_mix, [W_A, W_A + W_B])
    y = jnp.concatenate([rms_norm(y_a, g_a), rms_norm(y_b, g_b), rms_norm(y_c, g_c)], -1)
    x = layer_norm(ALPHA * x + y @ w_out, ln1_g, ln1_b)

    h = jnp.square(jax.nn.relu(x @ w_up + b_up)) @ w_down + b_down
    x = layer_norm(ALPHA * x + h, ln2_g, ln2_b)
    return x, (ckv, krope, kc, vc, v)


def setup_inputs(seed: int = 0) -> dict:
    key = jax.random.key(seed)
    ks = jax.random.split(key, 26)

    def nrm(k, shape, scale=1.0):
        return jax.random.normal(k, shape, jnp.float32) * scale

    return {
        'x_prompt': nrm(ks[0], (BATCH, SEQ, D_MODEL)),
        'x_sample': nrm(ks[1], (DEC_BATCH, DEC_SEQ, D_MODEL)),
        'cache_mla_ckv': nrm(ks[2], (DEPTH, DEC_BATCH, PAST_LEN, KV_LORA)),
        'cache_mla_krope': nrm(ks[3], (DEPTH, DEC_BATCH, PAST_LEN, ROPE_DIM)),
        'cache_sb_k': nrm(ks[4], (DEPTH, DEC_BATCH, PAST_LEN, H_C, D_C)),
        'cache_sb_v': nrm(ks[5], (DEPTH, DEC_BATCH, PAST_LEN, H_C, D_C)),
        'w_in': nrm(ks[6], (DEPTH, D_MODEL, W_IN_COLS), D_MODEL ** -0.5),
        'w_s': nrm(ks[7], (DEPTH, G_A, GMLP_CHUNK, GMLP_CHUNK), GMLP_CHUNK ** -0.5),
        'b_s': 1.0 + nrm(ks[8], (DEPTH, G_A, GMLP_CHUNK), 0.1),
        'g_cq': 1.0 + nrm(ks[9], (DEPTH, Q_LORA), 0.1),
        'g_ckv': 1.0 + nrm(ks[10], (DEPTH, KV_LORA), 0.1),
        'w_uq': nrm(ks[11], (DEPTH, Q_LORA, H_B, NOPE_DIM + ROPE_DIM), Q_LORA ** -0.5),
        'w_uk': nrm(ks[12], (DEPTH, H_B, KV_LORA, NOPE_DIM), KV_LORA ** -0.5),
        'w_uv': nrm(ks[13], (DEPTH, H_B, KV_LORA, V_DIM), KV_LORA ** -0.5),
        'g_mix': 1.0 + nrm(ks[14], (DEPTH, MIX_WIDTH), 0.1),
        'w_out': nrm(ks[15], (DEPTH, MIX_WIDTH, D_MODEL), MIX_WIDTH ** -0.5 * BETA),
        'ln1_g': 1.0 + nrm(ks[16], (DEPTH, D_MODEL), 0.1),
        'ln1_b': nrm(ks[17], (DEPTH, D_MODEL), 0.02),
        'w_up': nrm(ks[18], (DEPTH, D_MODEL, D_FF), D_MODEL ** -0.5 * BETA),
        'b_up': nrm(ks[19], (DEPTH, D_FF), 0.02),
        'w_down': nrm(ks[20], (DEPTH, D_FF, D_MODEL), D_FF ** -0.5 * BETA),
        'b_down': nrm(ks[21], (DEPTH, D_MODEL), 0.02),
        'ln2_g': 1.0 + nrm(ks[22], (DEPTH, D_MODEL), 0.1),
        'ln2_b': nrm(ks[23], (DEPTH, D_MODEL), 0.02),
    }


def reference(x_prompt, x_sample, cache_mla_ckv, cache_mla_krope, cache_sb_k, cache_sb_v,
              w_in, w_s, b_s, g_cq, g_ckv, w_uq, w_uk, w_uv, g_mix, w_out,
              ln1_g, ln1_b, w_up, b_up, w_down, b_down, ln2_g, ln2_b):
    past_len = cache_mla_ckv.shape[2]
    pos_p = jnp.arange(x_prompt.shape[1], dtype=jnp.int32)
    pos_s = past_len + jnp.arange(x_sample.shape[1], dtype=jnp.int32)
    yp, ys = x_prompt, x_sample
    ckv_p, kr_p, k_p, v_p = [], [], [], []
    ckv_s, kr_s, k_s, v_s, gv_s = [], [], [], [], []
    for l in range(DEPTH):
        params = (w_in[l], w_s[l], b_s[l], g_cq[l], g_ckv[l], w_uq[l], w_uk[l], w_uv[l], g_mix[l],
                  w_out[l], ln1_g[l], ln1_b[l], w_up[l], b_up[l], w_down[l], b_down[l],
                  ln2_g[l], ln2_b[l])
        yp, st_p = trunk_layer(yp, pos_p, None, *params)
        ys, st_s = trunk_layer(ys, pos_s, (cache_mla_ckv[l], cache_mla_krope[l],
                                           cache_sb_k[l], cache_sb_v[l]), *params)
        ckv_p.append(st_p[0]); kr_p.append(st_p[1]); k_p.append(st_p[2]); v_p.append(st_p[3])
        ckv_s.append(st_s[0]); kr_s.append(st_s[1]); k_s.append(st_s[2]); v_s.append(st_s[3])
        gv_s.append(st_s[4])
    return (yp, ys,
            jnp.stack(ckv_p), jnp.stack(kr_p), jnp.stack(k_p), jnp.stack(v_p),
            jnp.stack(ckv_s), jnp.stack(kr_s), jnp.stack(k_s), jnp.stack(v_s), jnp.stack(gv_s))
```

```cpp
#include <hip/hip_runtime.h>
#include <hip/hip_cooperative_groups.h>
#include <cstdio>
#include <cstdint>
namespace cg = cooperative_groups;
namespace pg8 {
#define PG8_LAS __attribute__((address_space(3)))
typedef unsigned short bf16_t;
typedef short bf16x8 __attribute__((ext_vector_type(8)));
typedef float f32x4 __attribute__((ext_vector_type(4)));
typedef unsigned u32x4 __attribute__((ext_vector_type(4)));
constexpr int BM = 256, BK = 64, HALF = 128, HTB = HALF * BK * 2  , STAGE_BYTES = 8 * HTB, NXCD = 8, WGM = 8;

__host__ __device__ __forceinline__ int lds_byte(int r, int c) { const int st = (r >> 4) * 2 + (c >> 5), rr = r & 15, cc = c & 31, ob = rr * 64 + cc * 2; return st * 1024 + (ob ^ (((ob >> 9) & 1) << 5)); }
__host__ __device__ __forceinline__ void stage_rc(int b, int& R, int& C) { const int st = b / 1024, sb = b % 1024, swz = sb ^ (((sb >> 9) & 1) << 5); R = (st >> 1) * 16 + swz / 64; C = (st & 1) * 32 + (swz % 64) / 2; }
__host__ __device__ __forceinline__ int perm32(int rho) { const int n = rho >> 4, i = rho & 15; return 8 * (i >> 2) + 4 * n + (i & 3); }

struct Unit { int pm, pn, ks; };
struct Gemm { const bf16_t* A; const bf16_t* Bt; int M, N, K, ld; };

struct StaticOrder {
    int nM, nN, nwg, G, c, rr;
    __host__ __device__ void init(int M, int N, int G_, int c_) { nM = M / BM; nN = N / BM; nwg = nM * nN; G = G_; c = c_; rr = 0; }
    __host__ __device__ bool next(int i, Unit& u) const {
        const int ii = rr ? rr - 1 - i : i; if (ii < 0) return false;
        const long L = (long)ii * G + c; if (L >= nwg) return false;
        int wgid = (int)L; { const int q = nwg / NXCD, r = nwg % NXCD, xcd = wgid % NXCD, off = wgid / NXCD; wgid = (xcd < r ? xcd * (q + 1) : r * (q + 1) + (xcd - r) * q) + off; }
        const int nig = WGM * nN, gid = wgid / nig, fm = gid * WGM, gsz = (nM - fm) < WGM ? (nM - fm) : WGM;
        u.pm = fm + ((wgid % nig) % gsz); u.pn = (wgid % nig) / gsz; u.ks = 0; return true;
    }
    __device__ __forceinline__ void a_ready(const Unit&) const {}
    __device__ __forceinline__ void done(const Unit&) const {}
};


struct SplitOrder {
    int pm, nN, nS, G, c;
    __device__ __forceinline__ bool next(int i, Unit& u) const { const int L = i * G + c; if (L >= nN * nS) return false; u.pm = pm; u.pn = L % nN; u.ks = L / nN; return true; }
    __device__ __forceinline__ void a_ready(const Unit&) const {}
    __device__ __forceinline__ void done(const Unit&) const {}
};
template <class Epi, class Sched>
__device__ __forceinline__ void gemm_phase(PG8_LAS unsigned char* lds, const Gemm g, const Sched& S, const Epi& E) {
    int tid_ = threadIdx.x; asm volatile("" : "+v"(tid_));
    const int tid = tid_, wid = __builtin_amdgcn_readfirstlane(tid >> 6), lane = tid & 63, wr = wid >> 2, wc = wid & 3, fr = lane & 15, fq = lane >> 4;
    const int K = g.K, nt = K / BK;
    unsigned voffA[2], voffB[2];
#pragma unroll
    for (int i = 0; i < 2; ++i) { int R, C; stage_rc(tid * 16 + i * 8192, R, C); const int Rb = Epi::PERM ? ((R & ~31) + perm32(R & 31)) : R;
        voffA[i] = (unsigned)(R * g.ld + C) * 2u; voffB[i] = (unsigned)(Rb * g.ld + C) * 2u; }
    const size_t kstep = (size_t)(BK * 2);
    const size_t hstep = (size_t)HALF * g.ld * 2;
    const size_t tstep = 2 * hstep;
    const unsigned ldsw = (unsigned)wid * 1024u;
    const int aoff = lds_byte(wr * 64 + fr, fq * 8), boff = lds_byte(wc * 32 + fr, fq * 8);
#define PG8_SA(b, h) (((b) * 2 + (h)) * HTB)
#define PG8_SB(b, h) ((4 + (b) * 2 + (h)) * HTB)
#define PG8_STAGE(bufoff, gbase, voff) do { _Pragma("unroll") for (int _i = 0; _i < 2; ++_i) \
        __builtin_amdgcn_global_load_lds((const unsigned*)((const char*)(gbase) + (voff)[_i]), (PG8_LAS unsigned*)(lds + (bufoff) + ldsw + _i * 8192), 16, 0, 0); } while (0)
#define PG8_LDA(dst, b, h) do { _Pragma("unroll") for (int m = 0; m < 4; ++m) _Pragma("unroll") for (int k = 0; k < 2; ++k) dst[m][k] = *(const PG8_LAS bf16x8*)(lds + PG8_SA(b, h) + aoff + m * 2048 + k * 1024); } while (0)
#define PG8_LDB(dst, b, h) do { _Pragma("unroll") for (int n = 0; n < 2; ++n) _Pragma("unroll") for (int k = 0; k < 2; ++k) dst[n][k] = *(const PG8_LAS bf16x8*)(lds + PG8_SB(b, h) + boff + n * 2048 + k * 1024); } while (0)
#define PG8_MMA(ai, bj, At, Bt) do { __builtin_amdgcn_s_setprio(1); _Pragma("unroll") for (int m = 0; m < 4; ++m) _Pragma("unroll") for (int n = 0; n < 2; ++n) _Pragma("unroll") for (int k = 0; k < 2; ++k) \
        acc[ai][bj][m][n] = __builtin_amdgcn_mfma_f32_16x16x32_bf16(Bt[n][k], At[m][k], acc[ai][bj][m][n], 0, 0, 0); __builtin_amdgcn_s_setprio(0); } while (0)
#define PG8_WAIT_V(n) asm volatile("s_waitcnt vmcnt(" #n ")" ::: "memory")
#define PG8_WAIT_L(n) asm volatile("s_waitcnt lgkmcnt(" #n ")" ::: "memory")
#define PG8_BAR __builtin_amdgcn_s_barrier()
#define PG8_SCHED __builtin_amdgcn_sched_barrier(0)
    Unit cur, nxt; int ui = 0;
    if (!S.next(0, cur)) return;
    f32x4 acc[2][2][4][2];
#pragma unroll
    for (int a = 0; a < 2; ++a)
#pragma unroll
        for (int b = 0; b < 2; ++b)
#pragma unroll
            for (int m = 0; m < 4; ++m)
#pragma unroll
                for (int n = 0; n < 2; ++n) acc[a][b][m][n] = (f32x4){0.f, 0.f, 0.f, 0.f};
    bf16x8 At[4][2], B0[2][2], B1[2][2];
    const size_t sstep = (size_t)K * 2;
    const char* cA = (const char*)g.A + (size_t)cur.pm * tstep + (size_t)cur.ks * sstep; const char* cB = (const char*)g.Bt + (size_t)cur.pn * tstep + (size_t)cur.ks * sstep;
    S.a_ready(cur);
    PG8_STAGE(PG8_SB(0, 0), cB, voffB); PG8_STAGE(PG8_SB(0, 1), cB + hstep, voffB); PG8_STAGE(PG8_SA(0, 0), cA, voffA); PG8_STAGE(PG8_SA(0, 1), cA + hstep, voffA);
    if (wr == 1) PG8_BAR;
    PG8_WAIT_V(2); PG8_BAR;
    PG8_STAGE(PG8_SB(1, 0), cB + kstep, voffB); PG8_STAGE(PG8_SA(1, 0), cA + kstep, voffA); PG8_STAGE(PG8_SB(1, 1), cB + hstep + kstep, voffB);
    PG8_WAIT_V(6); PG8_BAR;
    for (;;) {
        const bool has_next = S.next(ui + 1, nxt);
        const char* nA = has_next ? (const char*)g.A + (size_t)nxt.pm * tstep + (size_t)nxt.ks * sstep : cA; const char* nB = has_next ? (const char*)g.Bt + (size_t)nxt.pn * tstep + (size_t)nxt.ks * sstep : cB;
        for (int t = 0; t < nt; t += 2) {
            const bool last = (t == nt - 2);
            const char* a1 = cA + (size_t)(t + 1) * kstep;
            const char* a2 = last ? nA : cA + (size_t)(t + 2) * kstep; const char* b2 = last ? nB : cB + (size_t)(t + 2) * kstep;
            const char* a3 = a2 + kstep; const char* b3 = b2 + kstep;
            if (last && has_next) S.a_ready(nxt);
            PG8_LDB(B0, 0, 0); PG8_LDB(B1, 0, 1); PG8_SCHED; PG8_LDA(At, 0, 0); PG8_STAGE(PG8_SA(1, 1), a1 + hstep, voffA);
            PG8_WAIT_V(8); PG8_WAIT_L(0); PG8_BAR; PG8_MMA(0, 0, At, B0); PG8_MMA(0, 1, At, B1); PG8_BAR; PG8_SCHED;
            PG8_LDA(At, 0, 1); PG8_STAGE(PG8_SB(0, 0), b2, voffB); PG8_STAGE(PG8_SB(0, 1), b2 + hstep, voffB); PG8_STAGE(PG8_SA(0, 0), a2, voffA);
            PG8_WAIT_V(8); PG8_WAIT_L(0); PG8_BAR; PG8_MMA(1, 0, At, B0); PG8_MMA(1, 1, At, B1); PG8_BAR; PG8_SCHED;
            PG8_LDB(B0, 1, 0); PG8_LDB(B1, 1, 1); PG8_SCHED; PG8_LDA(At, 1, 0); PG8_STAGE(PG8_SA(0, 1), a2 + hstep, voffA);
            PG8_WAIT_V(8); PG8_WAIT_L(0); PG8_BAR; PG8_MMA(0, 0, At, B0); PG8_MMA(0, 1, At, B1); PG8_BAR; PG8_SCHED;
            PG8_LDA(At, 1, 1); PG8_STAGE(PG8_SB(1, 0), b3, voffB); PG8_STAGE(PG8_SB(1, 1), b3 + hstep, voffB); PG8_STAGE(PG8_SA(1, 0), a3, voffA);
            PG8_WAIT_V(8); PG8_WAIT_L(0); PG8_BAR; PG8_MMA(1, 0, At, B0); PG8_MMA(1, 1, At, B1); PG8_BAR; PG8_SCHED;
        }
        if constexpr (!Epi::AFTER_DRAIN) { E(acc, cur, wr, wc, fr, fq); S.done(cur); }
        if (!has_next) break;
#pragma unroll
        for (int a = 0; a < 2; ++a)
#pragma unroll
            for (int b = 0; b < 2; ++b)
#pragma unroll
                for (int m = 0; m < 4; ++m)
#pragma unroll
                    for (int n = 0; n < 2; ++n) acc[a][b][m][n] = (f32x4){0.f, 0.f, 0.f, 0.f};
        cur = nxt; cA = nA; cB = nB; ++ui;
    }
    PG8_WAIT_V(0);
    if (wr == 0) PG8_BAR;
    PG8_BAR;
    if constexpr (Epi::AFTER_DRAIN) { E.fused(acc, cur, wr, wc, fr, fq, lds, wid, lane); S.done(cur); }
#undef PG8_SA
#undef PG8_SB
#undef PG8_STAGE
#undef PG8_LDA
#undef PG8_LDB
#undef PG8_MMA
#undef PG8_WAIT_V
#undef PG8_WAIT_L
#undef PG8_BAR
#undef PG8_SCHED
}
}

using pg8::bf16_t; using pg8::bf16x8; using pg8::f32x4; using pg8::u32x4;
#define LAS __attribute__((address_space(3)))
typedef short s16x4 __attribute__((ext_vector_type(4)));
typedef float f32x16 __attribute__((ext_vector_type(16)));
typedef float f32x2v __attribute__((ext_vector_type(2)));
typedef __bf16 bf16x2v __attribute__((ext_vector_type(2)));
typedef unsigned u32x2 __attribute__((ext_vector_type(2)));
typedef unsigned u32x3 __attribute__((ext_vector_type(3)));

constexpr int DM = 1024, NPB = 16, SEQ = 2048, DEPTH = 4, NSB = 8, SSEQ = 16, PAST = 4096;
constexpr int NP = NPB * SEQ;
constexpr int NS = NSB * SSEQ;
constexpr int MT = NP + 256;
constexpr int SKS = 4160;
constexpr int SNK = PAST + SSEQ;
constexpr int KR = NP + NSB * SKS;
constexpr int WIN = 1984, DFF = 4096;
constexpr float EPS = 1e-5f;
constexpr float ALPHA = 1.6817928305074290f;
constexpr float LOG2E = 1.4426950408889634f;
constexpr float MLA_QS = 0.07216878364870322f * 1.4426950408889634f;
constexpr int NSPLIT = 8;
constexpr int NTAB = SEQ + SSEQ;

constexpr size_t O_YP = 0, O_YS = 33554432, O_CKVP = 33685504, O_KRP = 67239936, O_KP = 75628544, O_VP = 109182976,
                 O_CKVS = 142737408, O_KRS = 142868480, O_KS = 142901248, O_VS = 143032320, O_GV = 143163392;

constexpr size_t al256(size_t x) { return (x + 255) & ~(size_t)255; }
constexpr size_t WS_W1T = 0;
constexpr size_t SZ_W1T = (size_t)2048 * 1024 * 2;
constexpr size_t WS_WUQT = WS_W1T + DEPTH * SZ_W1T;
constexpr size_t SZ_WUQT = (size_t)768 * 384 * 2;
constexpr size_t WS_WKVT = WS_WUQT + DEPTH * SZ_WUQT;
constexpr size_t SZ_WKVT = (size_t)1024 * 256 * 2;
constexpr size_t WS_WOUTT = WS_WKVT + DEPTH * SZ_WKVT;
constexpr size_t SZ_WOUTT = (size_t)1024 * 1024 * 2;
constexpr size_t WS_WUPT = WS_WOUTT + DEPTH * SZ_WOUTT;
constexpr size_t SZ_WUPT = (size_t)4096 * 1024 * 2;
constexpr size_t WS_WDNT = WS_WUPT + DEPTH * SZ_WUPT;
constexpr int HLD = 4096 + 64;
constexpr size_t SZ_WDNT = (size_t)1024 * HLD * 2;
constexpr size_t WS_TAB = WS_WDNT + DEPTH * SZ_WDNT;
constexpr size_t WS_XF = al256(WS_TAB + (size_t)NTAB * 32 * 8);
constexpr size_t WS_XB = WS_XF + (size_t)MT * 1024 * 4;
constexpr size_t WS_CKVK = WS_XB + (size_t)MT * 1024 * 2;
constexpr size_t WS_KRK = WS_CKVK + (size_t)KR * 256 * 2;
constexpr size_t WS_KC = WS_KRK + (size_t)KR * 64 * 2;
constexpr size_t WS_VC = WS_KC + (size_t)KR * 256 * 2;
constexpr int PM_STRIDE = 16 * 128 + 32, PS_STRIDE = 16 * 64 + 16;
constexpr size_t WS_PM = WS_VC + (size_t)KR * 256 * 2;
constexpr size_t WS_PS = al256(WS_PM + (size_t)NSB * 4 * NSPLIT * PM_STRIDE * 4);
constexpr size_t WS_R = al256(WS_PS + (size_t)NSB * 4 * NSPLIT * PS_STRIDE * 4);
constexpr size_t WS_P = WS_R;
constexpr size_t WS_U = WS_P + (size_t)MT * 2048 * 2;
constexpr size_t WS_V = WS_U + (size_t)MT * 256 * 2;
constexpr size_t WS_CQN = WS_V + (size_t)MT * 256 * 2;
constexpr size_t WS_Q = WS_CQN + (size_t)MT * 384 * 2;
constexpr size_t WS_QC = WS_Q + (size_t)MT * 768 * 2;
constexpr size_t WS_YRAW = WS_QC + (size_t)MT * 256 * 2;
constexpr size_t WS_PS32 = WS_YRAW + (size_t)MT * 1024 * 2;
constexpr size_t WS_BAR = WS_PS32 + (size_t)8 * 256 * 1024 * 4;
constexpr size_t WS_END = WS_BAR + 16384;
constexpr size_t WS_Y = WS_Q;
constexpr size_t WS_H = WS_R;
static_assert((size_t)KR * 1024 * 2 == (size_t)MT * 2048 * 2, "KVEXP aliases P exactly");
static_assert(WS_R + (size_t)MT * HLD * 2 <= WS_BAR, "H fits in the aliased region");

struct Params { const float* in[24]; float* out; unsigned char* ws; };

struct Ctx {
    const float* in[24]; float* out; unsigned char* ws;
    int tid, lane, wave;
    LAS unsigned char* lds;
    float* sm;
};

__device__ __forceinline__ unsigned pk2(float a, float b) { f32x2v v = {a, b}; bf16x2v r = __builtin_convertvector(v, bf16x2v); return __builtin_bit_cast(unsigned, r); }
typedef _Float16 f16x2v __attribute__((ext_vector_type(2)));
__device__ __forceinline__ unsigned pkh(float a, float b) { f32x2v v = {a, b}; f16x2v r = __builtin_convertvector(v, f16x2v); return __builtin_bit_cast(unsigned, r); }
__device__ __forceinline__ f32x2v unpkh(unsigned u) { return __builtin_convertvector(__builtin_bit_cast(f16x2v, u), f32x2v); }
__device__ __forceinline__ float bflo(unsigned u) { return __uint_as_float(u << 16); }
__device__ __forceinline__ float bfhi(unsigned u) { return __uint_as_float(u & 0xffff0000u); }
__device__ __forceinline__ bf16_t f2bf(float a) { return (bf16_t)(pk2(a, 0.f) & 0xffffu); }
__device__ __forceinline__ float bf2f(bf16_t v) { return __uint_as_float((unsigned)v << 16); }
__device__ __forceinline__ float gelu_tanh(float x) {
    const float y = 0.7978845608028654f * (x + 0.044715f * x * x * x);
    const float e = __expf(2.0f * y);
    const float t = 1.0f - 2.0f * __builtin_amdgcn_rcpf(1.0f + e);
    return 0.5f * x * (1.0f + t);
}
#define DPPF(v, ctrl, rmask) __builtin_bit_cast(float, __builtin_amdgcn_update_dpp(0, __builtin_bit_cast(int, (v)), (ctrl), (rmask), 0xf, true))
__device__ __forceinline__ float gsum16(float v) {
    v += DPPF(v, 0xB1, 0xf); v += DPPF(v, 0x4E, 0xf); v += DPPF(v, 0x141, 0xf); v += DPPF(v, 0x140, 0xf);
    return v;
}
__device__ __forceinline__ float wsum(float v) {
    v = gsum16(v);
    v += DPPF(v, 0x142, 0xa); v += DPPF(v, 0x143, 0xc);
    return __builtin_bit_cast(float, __builtin_amdgcn_readlane(__builtin_bit_cast(int, v), 63));
}
__device__ __forceinline__ int pos_index(int row) { return row < NP ? (row & (SEQ - 1)) : (row < NP + NS ? SEQ + ((row - NP) & (SSEQ - 1)) : 0); }
__device__ __forceinline__ int key_row(int row) { return row < NP ? row : NP + ((row - NP) >> 4) * SKS + PAST + ((row - NP) & 15); }

struct EpiBf16 {
    static constexpr bool PERM = true, AFTER_DRAIN = false;
    bf16_t* O; int ldc;
    __device__ __forceinline__ void operator()(const f32x4 (&acc)[2][2][4][2], const pg8::Unit& u, int wr, int wc, int fr, int fq) const {
        const int row0 = u.pm * 256 + wr * 64 + fr, col0 = u.pn * 256 + wc * 32 + 8 * fq;
#pragma unroll
        for (int ai = 0; ai < 2; ++ai)
#pragma unroll
            for (int m = 0; m < 4; ++m) { bf16_t* rowp = O + (size_t)(row0 + ai * 128 + m * 16) * ldc + col0;
#pragma unroll
                for (int bj = 0; bj < 2; ++bj) { const f32x4 v0 = acc[ai][bj][m][0], v1 = acc[ai][bj][m][1];
                    u32x4 w; w.x = pk2(v0[0], v0[1]); w.y = pk2(v0[2], v0[3]); w.z = pk2(v1[0], v1[1]); w.w = pk2(v1[2], v1[3]);
                    *(u32x4*)(rowp + bj * 128) = w; } }
    }
};
struct EpiRelu2 {
    static constexpr bool PERM = true, AFTER_DRAIN = false;
    bf16_t* O; int ldc; const float* bias;
    __device__ __forceinline__ void operator()(const f32x4 (&acc)[2][2][4][2], const pg8::Unit& u, int wr, int wc, int fr, int fq) const {
        const int row0 = u.pm * 256 + wr * 64 + fr, col0 = u.pn * 256 + wc * 32 + 8 * fq;
        f32x4 bv[2][2];
#pragma unroll
        for (int bj = 0; bj < 2; ++bj)
#pragma unroll
            for (int n = 0; n < 2; ++n) bv[bj][n] = *(const f32x4*)(bias + col0 + bj * 128 + 4 * n);
#pragma unroll
        for (int ai = 0; ai < 2; ++ai)
#pragma unroll
            for (int m = 0; m < 4; ++m) { bf16_t* rowp = O + (size_t)(row0 + ai * 128 + m * 16) * ldc + col0;
#pragma unroll
                for (int bj = 0; bj < 2; ++bj) { f32x4 v0 = acc[ai][bj][m][0] + bv[bj][0], v1 = acc[ai][bj][m][1] + bv[bj][1];
#pragma unroll
                    for (int j = 0; j < 4; ++j) { const float a = fmaxf(v0[j], 0.f), b = fmaxf(v1[j], 0.f); v0[j] = a * a; v1[j] = b * b; }
                    u32x4 w; w.x = pk2(v0[0], v0[1]); w.y = pk2(v0[2], v0[3]); w.z = pk2(v1[0], v1[1]); w.w = pk2(v1[2], v1[3]);
                    *(u32x4*)(rowp + bj * 128) = w; } }
    }
};
struct EpiRes {
    static constexpr bool PERM = true, AFTER_DRAIN = false;
    bf16_t* T; const bf16_t* R; const float* bias;
    __device__ __forceinline__ void operator()(const f32x4 (&acc)[2][2][4][2], const pg8::Unit& u, int wr, int wc, int fr, int fq) const {
        const int row0 = u.pm * 256 + wr * 64 + fr, col0 = u.pn * 256 + wc * 32 + 8 * fq;
        f32x4 bv[2][2];
#pragma unroll
        for (int bj = 0; bj < 2; ++bj)
#pragma unroll
            for (int n = 0; n < 2; ++n) bv[bj][n] = bias ? *(const f32x4*)(bias + col0 + bj * 128 + 4 * n) : (f32x4){0.f, 0.f, 0.f, 0.f};
#pragma unroll
        for (int ai = 0; ai < 2; ++ai) {
            u32x4 xr[4][2];
#pragma unroll
            for (int m = 0; m < 4; ++m)
#pragma unroll
                for (int bj = 0; bj < 2; ++bj) xr[m][bj] = *(const u32x4*)(R + (size_t)(row0 + ai * 128 + m * 16) * 1024 + col0 + bj * 128);
#pragma unroll
            for (int m = 0; m < 4; ++m) { const size_t ro = (size_t)(row0 + ai * 128 + m * 16) * 1024 + col0;
#pragma unroll
                for (int bj = 0; bj < 2; ++bj) { const u32x4 w = xr[m][bj];
                    const f32x4 x0 = {bflo(w.x), bfhi(w.x), bflo(w.y), bfhi(w.y)}, x1 = {bflo(w.z), bfhi(w.z), bflo(w.w), bfhi(w.w)};
                    const f32x4 v0 = x0 * ALPHA + acc[ai][bj][m][0] + bv[bj][0], v1 = x1 * ALPHA + acc[ai][bj][m][1] + bv[bj][1];
                    u32x4 o; o.x = pkh(v0[0], v0[1]); o.y = pkh(v0[2], v0[3]); o.z = pkh(v1[0], v1[1]); o.w = pkh(v1[2], v1[3]);
                    *(u32x4*)(T + ro + bj * 128) = o; } }
        }
    }
};
struct EpiPart {
    static constexpr bool PERM = false, AFTER_DRAIN = false;
    float* X; int ldc; int rowsub; size_t sstride;
    __device__ __forceinline__ void operator()(const f32x4 (&acc)[2][2][4][2], const pg8::Unit& u, int wr, int wc, int fr, int fq) const {
        const int row0 = u.pm * 256 + wr * 64 + fr - rowsub, col0 = u.pn * 256 + wc * 32 + 4 * fq;
        float* base = X + (size_t)u.ks * sstride;
#pragma unroll
        for (int ai = 0; ai < 2; ++ai)
#pragma unroll
            for (int m = 0; m < 4; ++m) { float* rowp = base + (size_t)(row0 + ai * 128 + m * 16) * ldc + col0;
#pragma unroll
                for (int bj = 0; bj < 2; ++bj)
#pragma unroll
                    for (int n = 0; n < 2; ++n) *(f32x4*)(rowp + bj * 128 + n * 16) = acc[ai][bj][m][n]; }
    }
};
struct EpiQ {
    static constexpr bool PERM = true, AFTER_DRAIN = false;
    bf16_t* Q; const float* tab;
    __device__ __forceinline__ void operator()(const f32x4 (&acc)[2][2][4][2], const pg8::Unit& u, int wr, int wc, int fr, int fq) const {
        const int row0 = u.pm * 256 + wr * 64 + fr;
#pragma unroll
        for (int bj = 0; bj < 2; ++bj) {
            const int cbase = u.pn * 256 + bj * 128 + wc * 32;
            const int rel = cbase % 192;
            if (rel < 128) {
#pragma unroll
                for (int ai = 0; ai < 2; ++ai)
#pragma unroll
                    for (int m = 0; m < 4; ++m) { const f32x4 v0 = acc[ai][bj][m][0] * MLA_QS, v1 = acc[ai][bj][m][1] * MLA_QS;
                        u32x4 w; w.x = pk2(v0[0], v0[1]); w.y = pk2(v0[2], v0[3]); w.z = pk2(v1[0], v1[1]); w.w = pk2(v1[2], v1[3]);
                        *(u32x4*)(Q + (size_t)(row0 + ai * 128 + m * 16) * 768 + cbase + 8 * fq) = w; }
            } else {
                const int hb = cbase - rel + 128;
                const int i0 = 4 * (4 * (wc & 1) + fq);
#pragma unroll
                for (int ai = 0; ai < 2; ++ai) {
                    f32x4 tc[4][2];
#pragma unroll
                    for (int m = 0; m < 4; ++m) { const float* tp = tab + (size_t)pos_index(row0 + ai * 128 + m * 16) * 64 + 2 * i0; tc[m][0] = *(const f32x4*)tp; tc[m][1] = *(const f32x4*)(tp + 4); }
#pragma unroll
                    for (int m = 0; m < 4; ++m) { const int row = row0 + ai * 128 + m * 16;
                        const f32x4 cs0 = tc[m][0], cs1 = tc[m][1];
                        const f32x4 x1 = acc[ai][bj][m][0] * MLA_QS, x2 = acc[ai][bj][m][1] * MLA_QS;
                        const float a0 = x1[0] * cs0[0] - x2[0] * cs0[1], b0 = x2[0] * cs0[0] + x1[0] * cs0[1];
                        const float a1 = x1[1] * cs0[2] - x2[1] * cs0[3], b1 = x2[1] * cs0[2] + x1[1] * cs0[3];
                        const float a2 = x1[2] * cs1[0] - x2[2] * cs1[1], b2 = x2[2] * cs1[0] + x1[2] * cs1[1];
                        const float a3 = x1[3] * cs1[2] - x2[3] * cs1[3], b3 = x2[3] * cs1[2] + x1[3] * cs1[3];
                        bf16_t* qp = Q + (size_t)row * 768 + hb + i0;
                        u32x2 wa; wa.x = pk2(a0, a1); wa.y = pk2(a2, a3); *(u32x2*)qp = wa;
                        u32x2 wb; wb.x = pk2(b0, b1); wb.y = pk2(b2, b3); *(u32x2*)(qp + 32) = wb; }
                }
            }
        }
    }
};
template <class Epi>
__device__ __forceinline__ void run_gemm(const Ctx& c, const bf16_t* A, const bf16_t* Bt, int M, int N, int K, const Epi& E, int ld = 0, bool rev = false, bool rrev = false) {
    asm volatile("" : "+s"(K), "+s"(N), "+s"(M));
    pg8::Gemm g{A, Bt, M, N, K, ld ? ld : K}; pg8::StaticOrder S; S.init(M, N, (int)gridDim.x, rev ? (int)(gridDim.x - 1 - blockIdx.x) : (int)blockIdx.x);
    if (rrev) S.rr = (S.nwg + (int)gridDim.x - 1) / (int)gridDim.x;
    pg8::gemm_phase<Epi, pg8::StaticOrder>(c.lds, g, S, E);
}
template <class Epi>
__device__ __forceinline__ void run_gemm_split(const Ctx& c, const bf16_t* A, const bf16_t* Bt, int pm, int N, int K, int KS, const Epi& E, int ld = 0) {
    asm volatile("" : "+s"(K), "+s"(N), "+s"(KS));
    pg8::Gemm g{A, Bt, 256 * (pm + 1), N, KS, ld ? ld : K}; pg8::SplitOrder S{pm, N / 256, K / KS, (int)gridDim.x, (int)blockIdx.x};
    pg8::gemm_phase<Epi, pg8::SplitOrder>(c.lds, g, S, E);
}

#define XB_TMO      128
#define XB_XCNT(j)  (256  + 64 * (j))
#define XB_XSUB(j)  (1280 + 64 * (j))
#define XB_XGEN(j)  (2304 + 64 * (j))
#define XB_TOP      3328
#define XB_TOPGEN   3392
#define XCD_BAR_WORDS 3456
#define XB_SPIN_CAP (1u << 18)
__device__ __forceinline__ unsigned xb_ld(unsigned* p)              { return __hip_atomic_load(p, __ATOMIC_RELAXED, __HIP_MEMORY_SCOPE_AGENT); }
__device__ __forceinline__ unsigned xb_add(unsigned* p, unsigned v) { return __hip_atomic_fetch_add(p, v, __ATOMIC_RELAXED, __HIP_MEMORY_SCOPE_AGENT); }
__device__ __forceinline__ unsigned xb_xcc_id() { return (unsigned)__builtin_amdgcn_s_getreg((3 << 11) | 20) & 0xFu; }
#define XB_SPIN(cond, bar) do { unsigned _sp = 0; while (cond) { __builtin_amdgcn_s_sleep(1); \
    if ((++_sp & 255u) == 0u) { if (xb_ld(&(bar)[XB_TMO])) break; if (_sp > XB_SPIN_CAP) { atomicAdd(&(bar)[XB_TMO], 1u); break; } } } } while (0)
struct XcdBarrier { unsigned* bar; unsigned x; volatile LAS unsigned* st; };
__device__ __forceinline__ XcdBarrier xcd_barrier_post(unsigned* bar, volatile LAS unsigned* st) {
    XcdBarrier b; b.bar = bar; b.x = xb_xcc_id(); b.st = st;
    if (threadIdx.x == 0) (void)xb_add(&bar[XB_XCNT(b.x)], 1u);
    return b;
}
__device__ __forceinline__ void xcd_barrier_complete(unsigned* bar, unsigned x, unsigned& nloc, unsigned& nx) {
    const unsigned G = gridDim.x * gridDim.y * gridDim.z;
    unsigned sum, cnt, mine, sp = 0u;
    for (;;) {
        sum = 0u; cnt = 0u; mine = 0u;
#pragma unroll
        for (unsigned j = 0; j < 16; ++j) { const unsigned c = xb_ld(&bar[XB_XCNT(j)]); sum += c; cnt += (c > 0u) ? 1u : 0u; mine = (j == x) ? c : mine; }
        if (sum == G) break;
        __builtin_amdgcn_s_sleep(1);
        if ((++sp & 255u) == 0u) { if (xb_ld(&bar[XB_TMO])) break; if (sp > XB_SPIN_CAP) { atomicAdd(&bar[XB_TMO], 1u); break; } }
    }
    nloc = mine > 0u ? mine : 1u; nx = cnt > 0u ? cnt : 1u;
}
__device__ __forceinline__ void xcd_barrier(const XcdBarrier& b) {
    asm volatile("s_waitcnt vmcnt(0)" ::: "memory");
    __syncthreads();
    if (threadIdx.x == 0) {
        unsigned* bar = b.bar;
        unsigned bx = b.x; asm volatile("" : "+s"(bx));
        __builtin_amdgcn_s_waitcnt(0);
        unsigned nloc = b.st[0], nx = b.st[1];
        if (nloc == 0u) { xcd_barrier_complete(bar, bx, nloc, nx); b.st[0] = nloc; b.st[1] = nx; }
        const unsigned old = xb_add(&bar[XB_XSUB(bx)], 1u);
        const unsigned gen = old / nloc;
        if (old + 1u == (gen + 1u) * nloc) {
            __builtin_amdgcn_fence(__ATOMIC_RELEASE, "agent");
            asm volatile("s_waitcnt vmcnt(0)" ::: "memory");
            const unsigned og = xb_add(&bar[XB_TOP], 1u);
            const unsigned tg = og / nx;
            if (og + 1u == (tg + 1u) * nx) xb_add(&bar[XB_TOPGEN], 1u);
            else XB_SPIN(xb_ld(&bar[XB_TOPGEN]) == tg, bar);
            __builtin_amdgcn_fence(__ATOMIC_ACQUIRE, "agent");
            xb_add(&bar[XB_XGEN(bx)], 1u);
            asm volatile("s_waitcnt vmcnt(0)" ::: "memory");
        } else {
            XB_SPIN(xb_ld(&bar[XB_XGEN(bx)]) == gen, bar);
            __builtin_amdgcn_fence(__ATOMIC_ACQUIRE, "agent");
            asm volatile("s_waitcnt vmcnt(0)" ::: "memory");
        }
    }
    __syncthreads();
}
__device__ __forceinline__ void cache_convert(const Ctx& c, int l, int wg0, int part, int nparts);
__device__ __forceinline__ int uq_rowmap(int n) {
    const int h = n / 192, d = n - h * 192;
    if (d < 128) return n;
    const int e = d - 128, nn = e >> 5, i = e & 31;
    return h * 192 + 128 + 8 * (i >> 2) + 4 * nn + (i & 3);
}
struct TcTile { const float* src; bf16_t* dst; int ldS, ldD, k0, n0; bool uq; };
__device__ __forceinline__ TcTile tc_decode(const Ctx& c, int idx) {
    const float* w_in = c.in[6]; const float* w_uq = c.in[11]; const float* w_uk = c.in[12]; const float* w_uv = c.in[13];
    const float* w_out = c.in[15]; const float* w_up = c.in[18]; const float* w_down = c.in[20];
    constexpr int T_IN = 16 * 31, T_UQ = 6 * 12, T_UK = 4 * 4 * 2, T_UV = T_UK, T_OUT = 16 * 16, T_UP = 16 * 64, T_DN = 64 * 16;
    constexpr int TPL = T_IN + T_UQ + T_UK + T_UV + T_OUT + T_UP + T_DN;
    const int l = idx / TPL; int t = idx - l * TPL;
    TcTile d; d.uq = false;
    if (t < T_IN) { d.src = w_in + (size_t)l * 1024 * WIN; d.ldS = WIN; d.k0 = (t / 31) * 64; d.n0 = (t % 31) * 64; d.dst = (bf16_t*)(c.ws + WS_W1T + l * SZ_W1T); d.ldD = 1024; return d; }
    t -= T_IN;
    if (t < T_UQ) { d.src = w_uq + (size_t)l * 384 * 768; d.ldS = 768; d.k0 = (t / 12) * 64; d.n0 = (t % 12) * 64; d.dst = (bf16_t*)(c.ws + WS_WUQT + l * SZ_WUQT); d.ldD = 384; d.uq = true; return d; }
    t -= T_UQ;
    if (t < T_UK + T_UV) { const bool isv = t >= T_UK; if (isv) t -= T_UK; const int h = t / 8, r = t % 8;
        d.src = (isv ? w_uv : w_uk) + ((size_t)l * 4 + h) * 256 * 128; d.ldS = 128; d.k0 = (r / 2) * 64; d.n0 = (r % 2) * 64;
        d.dst = (bf16_t*)(c.ws + WS_WKVT + l * SZ_WKVT) + (size_t)((isv ? 512 : 0) + h * 128) * 256; d.ldD = 256; return d; }
    t -= T_UK + T_UV;
    if (t < T_OUT) { d.src = w_out + (size_t)l * 1024 * 1024; d.ldS = 1024; d.k0 = (t / 16) * 64; d.n0 = (t % 16) * 64; d.dst = (bf16_t*)(c.ws + WS_WOUTT + l * SZ_WOUTT); d.ldD = 1024; return d; }
    t -= T_OUT;
    if (t < T_UP) { d.src = w_up + (size_t)l * 1024 * 4096; d.ldS = 4096; d.k0 = (t / 64) * 64; d.n0 = (t % 64) * 64; d.dst = (bf16_t*)(c.ws + WS_WUPT + l * SZ_WUPT); d.ldD = 1024; return d; }
    t -= T_UP;
    d.src = w_down + (size_t)l * 4096 * 1024; d.ldS = 1024; d.k0 = (t / 16) * 64; d.n0 = (t % 16) * 64; d.dst = (bf16_t*)(c.ws + WS_WDNT + l * SZ_WDNT); d.ldD = HLD; return d;
}
__device__ __forceinline__ void tc_load(const Ctx& c, const TcTile& d, f32x4& a, f32x4& b) {
    const int r = c.tid >> 3, c8 = (c.tid & 7) * 8; const float* p = d.src + (size_t)(d.k0 + r) * d.ldS + d.n0 + c8;
    a = __builtin_nontemporal_load((const f32x4*)p); b = __builtin_nontemporal_load((const f32x4*)(p + 4));
}
__device__ __forceinline__ void tc_store(const Ctx& c, const TcTile& d, const f32x4& a, const f32x4& b) {
    float* sm = c.sm;
    const int r = c.tid >> 3, c8 = (c.tid & 7) * 8;
    __syncthreads();
#pragma unroll
    for (int j = 0; j < 4; ++j) { sm[r * 65 + c8 + j] = a[j]; sm[r * 65 + c8 + 4 + j] = b[j]; }
    __syncthreads();
    float v[8];
#pragma unroll
    for (int j = 0; j < 8; ++j) v[j] = sm[(c8 + j) * 65 + r];
    const int n = d.n0 + r; const int drow = d.uq ? uq_rowmap(n) : n;
    u32x4 w; w.x = pk2(v[0], v[1]); w.y = pk2(v[2], v[3]); w.z = pk2(v[4], v[5]); w.w = pk2(v[6], v[7]);
    *(u32x4*)(d.dst + (size_t)drow * d.ldD + d.k0 + c8) = w;
}
__device__ __forceinline__ void phase_prep(const Ctx& c) {
    constexpr int TPL = 16 * 31 + 6 * 12 + 2 * 4 * 4 * 2 + 16 * 16 + 16 * 64 + 64 * 16;
    {
        int idx = blockIdx.x; const int total = DEPTH * TPL, G = gridDim.x;
        f32x4 a = {0.f, 0.f, 0.f, 0.f}, b = a;
        if (idx < total) { const TcTile d = tc_decode(c, idx); tc_load(c, d, a, b); }
        while (idx < total) {
            const int nidx = idx + G; f32x4 na = a, nb = b;
            if (nidx < total) { const TcTile nd = tc_decode(c, nidx); tc_load(c, nd, na, nb); }
            { const TcTile d = tc_decode(c, idx); tc_store(c, d, a, b); }
            a = na; b = nb; idx = nidx;
        }
    }
    const size_t gt = (size_t)blockIdx.x * 512 + c.tid, gn = (size_t)gridDim.x * 512;
    for (size_t i = gt; i < (size_t)DEPTH * 64 * 1024 / 8; i += gn) { const size_t l = i / (64 * 128), r = i % (64 * 128);
        *(u32x4*)(c.ws + WS_W1T + l * SZ_W1T + (size_t)1984 * 2048 + r * 16) = (u32x4){0u, 0u, 0u, 0u}; }
    { const float* xp = c.in[0]; const float* xs = c.in[1]; float* XF = (float*)(c.ws + WS_XF); bf16_t* XB = (bf16_t*)(c.ws + WS_XB);
      for (size_t i0 = gt; i0 < (size_t)MT * 256; i0 += 4 * gn) { f32x4 v[4];
#pragma unroll
          for (int u = 0; u < 4; ++u) { const size_t e = (i0 + u * gn) * 4;
              if (e < (size_t)NP * 1024) v[u] = __builtin_nontemporal_load((const f32x4*)(xp + e)); else if (e < (size_t)(NP + NS) * 1024) v[u] = *(const f32x4*)(xs + (e - (size_t)NP * 1024)); else v[u] = (f32x4){0.f, 0.f, 0.f, 0.f}; }
#pragma unroll
          for (int u = 0; u < 4; ++u) { const size_t e = (i0 + u * gn) * 4; if (e < (size_t)MT * 1024) {
              if (e >= (size_t)NP * 1024) *(f32x4*)(XF + e) = v[u] * ALPHA; u32x2 w; w.x = pk2(v[u][0], v[u][1]); w.y = pk2(v[u][2], v[u][3]); *(u32x2*)(XB + e) = w; } } } }
    for (size_t i = gt; i < (size_t)NSB * 48 * 832 / 8; i += gn) { const size_t e = i * 8, b = e / (48 * 832), r = e % (48 * 832), row = NP + b * SKS + SNK + r / 832, col = r % 832;
        bf16_t* dst; if (col < 256) dst = (bf16_t*)(c.ws + WS_CKVK) + row * 256 + col; else if (col < 512) dst = (bf16_t*)(c.ws + WS_KC) + row * 256 + (col - 256);
        else if (col < 768) dst = (bf16_t*)(c.ws + WS_VC) + row * 256 + (col - 512); else dst = (bf16_t*)(c.ws + WS_KRK) + row * 64 + (col - 768);
        *(u32x4*)dst = (u32x4){0u, 0u, 0u, 0u}; }
    cache_convert(c, 0, 0, 0, 1);
    { float* tab = (float*)(c.ws + WS_TAB);
      for (size_t i = gt; i < (size_t)NTAB * 32; i += gn) { const int pi = (int)(i >> 5), k = (int)(i & 31); const int pos = pi < SEQ ? pi : PAST + (pi - SEQ);
          const float inv = (float)exp(-(double)k * 0.28782313662425574);
          const float ang = (float)pos * inv;
          double rev = (double)ang * 0.15915494309189535; rev -= rint(rev);
          tab[i * 2] = __builtin_amdgcn_cosf((float)rev); tab[i * 2 + 1] = __builtin_amdgcn_sinf((float)rev); } }
}

__device__ __forceinline__ void cache_convert(const Ctx& c, int l, int wg0, int part, int nparts) {
    if ((int)blockIdx.x < wg0) return;
    bf16_t* CKVK = (bf16_t*)(c.ws + WS_CKVK); bf16_t* KRK = (bf16_t*)(c.ws + WS_KRK); bf16_t* KC = (bf16_t*)(c.ws + WS_KC); bf16_t* VC = (bf16_t*)(c.ws + WS_VC);
    const size_t gt = (size_t)(blockIdx.x - wg0) * 512 + c.tid, gn = (size_t)(gridDim.x - wg0) * 512;
    { const float* cckv = c.in[2] + (size_t)l * NSB * PAST * 256; const float* ck = c.in[4] + (size_t)l * NSB * PAST * 256; const float* cv = c.in[5] + (size_t)l * NSB * PAST * 256;
      const size_t lo1 = (size_t)NSB * PAST * 64 / nparts * part, hi1 = lo1 + (size_t)NSB * PAST * 64 / nparts;
      for (size_t i0 = lo1 + gt; i0 < hi1; i0 += 4 * gn) {
          f32x4 a[4], k[4], v[4];
#pragma unroll
          for (int u = 0; u < 4; ++u) { const size_t i = i0 + u * gn; if (i < hi1) { const size_t tok = i >> 6, cc = (i & 63) * 4;
              a[u] = __builtin_nontemporal_load((const f32x4*)(cckv + tok * 256 + cc)); k[u] = __builtin_nontemporal_load((const f32x4*)(ck + tok * 256 + cc)); v[u] = __builtin_nontemporal_load((const f32x4*)(cv + tok * 256 + cc)); } }
#pragma unroll
          for (int u = 0; u < 4; ++u) { const size_t i = i0 + u * gn; if (i < hi1) { const size_t tok = i >> 6, cc = (i & 63) * 4, b = tok >> 12, j = tok & 4095, kr = NP + b * SKS + j;
              u32x2 o; o.x = pk2(a[u][0], a[u][1]); o.y = pk2(a[u][2], a[u][3]); *(u32x2*)(CKVK + kr * 256 + cc) = o;
              o.x = pk2(k[u][0], k[u][1]); o.y = pk2(k[u][2], k[u][3]); *(u32x2*)(KC + kr * 256 + cc) = o;
              o.x = pk2(v[u][0], v[u][1]); o.y = pk2(v[u][2], v[u][3]); *(u32x2*)(VC + kr * 256 + cc) = o; } } }
      const float* ckr = c.in[3] + (size_t)l * NSB * PAST * 64;
      const size_t lo2 = (size_t)NSB * PAST * 16 / nparts * part, hi2 = lo2 + (size_t)NSB * PAST * 16 / nparts;
      for (size_t i0 = lo2 + gt; i0 < hi2; i0 += 4 * gn) {
          f32x4 a[4];
#pragma unroll
          for (int u = 0; u < 4; ++u) { const size_t i = i0 + u * gn; if (i < hi2) { const size_t tok = i >> 4, cc = (i & 15) * 4; a[u] = __builtin_nontemporal_load((const f32x4*)(ckr + tok * 64 + cc)); } }
#pragma unroll
          for (int u = 0; u < 4; ++u) { const size_t i = i0 + u * gn; if (i < hi2) { const size_t tok = i >> 4, cc = (i & 15) * 4, b = tok >> 12, j = tok & 4095, kr = NP + b * SKS + j;
              u32x2 o; o.x = pk2(a[u][0], a[u][1]); o.y = pk2(a[u][2], a[u][3]); *(u32x2*)(KRK + kr * 64 + cc) = o; } } } }
}
struct P1Row { u32x2 wu, wv, wckv, wq, wk, wvv; unsigned cq0, cq1, cq2; bf16_t r1, r2; };
__device__ __forceinline__ void p1_load(P1Row& d, const bf16_t* pr, int lane) {
    d.wu = __builtin_nontemporal_load((const u32x2*)(pr + 4 * lane)); d.wv = __builtin_nontemporal_load((const u32x2*)(pr + 256 + 4 * lane));
    const unsigned* pw = (const unsigned*)(pr + 512 + 6 * lane); d.cq0 = pw[0]; d.cq1 = pw[1]; d.cq2 = pw[2];
    d.wckv = *(const u32x2*)(pr + 896 + 4 * lane); d.r1 = pr[1152 + (lane & 31)]; d.r2 = pr[1152 + 32 + (lane & 31)];
    d.wq = __builtin_nontemporal_load((const u32x2*)(pr + 1216 + 4 * lane)); d.wk = __builtin_nontemporal_load((const u32x2*)(pr + 1472 + 4 * lane)); d.wvv = __builtin_nontemporal_load((const u32x2*)(pr + 1728 + 4 * lane));
}
__device__ __forceinline__ void p1_load32(P1Row& d, const float* pr, int lane) {
    constexpr size_t SS = (size_t)256 * 2048;
    auto ld4 = [&](int off) { f32x4 v = *(const f32x4*)(pr + off);
#pragma unroll
        for (int s = 1; s < 4; ++s) v += *(const f32x4*)(pr + s * SS + off);
        u32x2 o; o.x = pk2(v[0], v[1]); o.y = pk2(v[2], v[3]); return o; };
    auto ld1 = [&](int off) { float v = pr[off];
#pragma unroll
        for (int s = 1; s < 4; ++s) v += pr[s * SS + off];
        return v; };
    d.wu = ld4(4 * lane); d.wv = ld4(256 + 4 * lane);
    { const int o = 512 + 6 * lane; d.cq0 = pk2(ld1(o), ld1(o + 1)); d.cq1 = pk2(ld1(o + 2), ld1(o + 3)); d.cq2 = pk2(ld1(o + 4), ld1(o + 5)); }
    d.wckv = ld4(896 + 4 * lane); d.r1 = f2bf(ld1(1152 + (lane & 31))); d.r2 = f2bf(ld1(1152 + 32 + (lane & 31)));
    d.wq = ld4(1216 + 4 * lane); d.wk = ld4(1472 + 4 * lane); d.wvv = ld4(1728 + 4 * lane);
}
__device__ __forceinline__ void p1_row(const Ctx& c, int l, int row, const P1Row& d, const float* g_cq, const float* g_ckv, const float* tab) {
    bf16_t* U = (bf16_t*)(c.ws + WS_U); bf16_t* V = (bf16_t*)(c.ws + WS_V); bf16_t* CQN = (bf16_t*)(c.ws + WS_CQN); bf16_t* QC = (bf16_t*)(c.ws + WS_QC);
    bf16_t* CKVK = (bf16_t*)(c.ws + WS_CKVK); bf16_t* KRK = (bf16_t*)(c.ws + WS_KRK); bf16_t* KC = (bf16_t*)(c.ws + WS_KC); bf16_t* VC = (bf16_t*)(c.ws + WS_VC);
    const int lane = c.lane;
    const bool real = row < NP + NS, samp = row >= NP;
    const int srow = row - NP;
    const int krow = key_row(real ? row : 0);
    { const u32x2 w = d.wu;
      const float a0 = gelu_tanh(bflo(w.x)), a1 = gelu_tanh(bfhi(w.x)), a2 = gelu_tanh(bflo(w.y)), a3 = gelu_tanh(bfhi(w.y));
      u32x2 o; o.x = pk2(a0, a1); o.y = pk2(a2, a3); *(u32x2*)(U + (size_t)row * 256 + 4 * lane) = o; }
    { const u32x2 w = d.wv;
      float a0 = gelu_tanh(bflo(w.x)), a1 = gelu_tanh(bfhi(w.x)), a2 = gelu_tanh(bflo(w.y)), a3 = gelu_tanh(bfhi(w.y));
      const float mu = gsum16(a0 + a1 + a2 + a3) * (1.0f / 64.0f);
      a0 -= mu; a1 -= mu; a2 -= mu; a3 -= mu;
      const float var = gsum16(a0 * a0 + a1 * a1 + a2 * a2 + a3 * a3) * (1.0f / 64.0f);
      const float rs = rsqrtf(var + EPS); a0 *= rs; a1 *= rs; a2 *= rs; a3 *= rs;
      u32x2 o; o.x = pk2(a0, a1); o.y = pk2(a2, a3); *(u32x2*)(V + (size_t)row * 256 + 4 * lane) = o;
      if (real && samp) *(f32x4*)(c.out + O_GV + ((size_t)l * NS + srow) * 256 + 4 * lane) = (f32x4){a0, a1, a2, a3}; }
    { float a[6] = {bflo(d.cq0), bfhi(d.cq0), bflo(d.cq1), bfhi(d.cq1), bflo(d.cq2), bfhi(d.cq2)};
      float ss = 0.f;
#pragma unroll
      for (int j = 0; j < 6; ++j) ss += a[j] * a[j];
      const float rs = rsqrtf(wsum(ss) * (1.0f / 384.0f) + EPS);
#pragma unroll
      for (int j = 0; j < 6; ++j) a[j] *= rs * g_cq[6 * lane + j];
      unsigned* po = (unsigned*)(CQN + (size_t)row * 384 + 6 * lane); po[0] = pk2(a[0], a[1]); po[1] = pk2(a[2], a[3]); po[2] = pk2(a[4], a[5]); }
    { const u32x2 w = d.wckv;
      float a0 = bflo(w.x), a1 = bfhi(w.x), a2 = bflo(w.y), a3 = bfhi(w.y);
      const float rs = rsqrtf(wsum(a0 * a0 + a1 * a1 + a2 * a2 + a3 * a3) * (1.0f / 256.0f) + EPS);
      const f32x4 g = *(const f32x4*)(g_ckv + 4 * lane);
      a0 *= rs * g[0]; a1 *= rs * g[1]; a2 *= rs * g[2]; a3 *= rs * g[3];
      if (real) {
          float* op = samp ? c.out + O_CKVS + ((size_t)l * NS + srow) * 256 : c.out + O_CKVP + ((size_t)l * NP + row) * 256;
          __builtin_nontemporal_store((f32x4){a0, a1, a2, a3}, (f32x4*)(op + 4 * lane));
          u32x2 o; o.x = pk2(a0, a1); o.y = pk2(a2, a3); *(u32x2*)(CKVK + (size_t)krow * 256 + 4 * lane) = o; } }
    { const int i = lane & 31; const float x1 = bf2f(d.r1), x2 = bf2f(d.r2);
      const f32x2v t = *(const f32x2v*)(tab + (size_t)pos_index(row) * 64 + 2 * i);
      const float o1 = x1 * t.x - x2 * t.y, o2 = x2 * t.x + x1 * t.y;
      if (real && lane < 32) {
          float* op = samp ? c.out + O_KRS + ((size_t)l * NS + srow) * 64 : c.out + O_KRP + ((size_t)l * NP + row) * 64;
          __builtin_nontemporal_store(o1, op + i); __builtin_nontemporal_store(o2, op + 32 + i);
          KRK[(size_t)krow * 64 + i] = f2bf(o1); KRK[(size_t)krow * 64 + 32 + i] = f2bf(o2); } }
    { const u32x2 w = d.wq;
      u32x2 o; o.x = pk2(bflo(w.x) * 0.125f, bfhi(w.x) * 0.125f); o.y = pk2(bflo(w.y) * 0.125f, bfhi(w.y) * 0.125f);
      *(u32x2*)(QC + (size_t)row * 256 + 4 * lane) = o; }
    if (real) {
        const u32x2 wk = d.wk, wv = d.wvv;
        float* ok = samp ? c.out + O_KS + ((size_t)l * NS + srow) * 256 : c.out + O_KP + ((size_t)l * NP + row) * 256;
        float* ov = samp ? c.out + O_VS + ((size_t)l * NS + srow) * 256 : c.out + O_VP + ((size_t)l * NP + row) * 256;
        __builtin_nontemporal_store((f32x4){bflo(wk.x), bfhi(wk.x), bflo(wk.y), bfhi(wk.y)}, (f32x4*)(ok + 4 * lane));
        __builtin_nontemporal_store((f32x4){bflo(wv.x), bfhi(wv.x), bflo(wv.y), bfhi(wv.y)}, (f32x4*)(ov + 4 * lane));
        *(u32x2*)(KC + (size_t)krow * 256 + 4 * lane) = wk; *(u32x2*)(VC + (size_t)krow * 256 + 4 * lane) = wv;
    }
}
__device__ __forceinline__ void phase_post1(const Ctx& c, int l) {
    const bf16_t* P = (const bf16_t*)(c.ws + WS_P); const float* PS32 = (const float*)(c.ws + WS_PS32);
    bf16_t* CKVK = (bf16_t*)(c.ws + WS_CKVK); bf16_t* KRK = (bf16_t*)(c.ws + WS_KRK); bf16_t* KC = (bf16_t*)(c.ws + WS_KC); bf16_t* VC = (bf16_t*)(c.ws + WS_VC);
    const float* tab = (const float*)(c.ws + WS_TAB);
    const float* g_cq = c.in[9] + l * 384; const float* g_ckv = c.in[10] + l * 256;
    const int W = gridDim.x * 8;
    for (int row = blockIdx.x * 8 + c.wave; row < NP; row += 2 * W) {
        const int row2 = row + W; const bool has2 = row2 < NP;
        P1Row d0, d1;
        p1_load(d0, P + (size_t)row * 2048, c.lane);
        p1_load(d1, P + (size_t)(has2 ? row2 : row) * 2048, c.lane);
        p1_row(c, l, row, d0, g_cq, g_ckv, tab);
        if (has2) p1_row(c, l, row2, d1, g_cq, g_ckv, tab);
    }
    for (int row = NP + blockIdx.x * 8 + c.wave; row < MT; row += W) {
        P1Row d0;
        p1_load32(d0, PS32 + (size_t)(row - NP) * 2048, c.lane);
        p1_row(c, l, row, d0, g_cq, g_ckv, tab);
    }
}
#define EX2(x) __builtin_amdgcn_exp2f(x)
typedef unsigned u32x2s __attribute__((ext_vector_type(2)));
__device__ __forceinline__ float xor32(float v, int lane) {
    const unsigned x = __builtin_bit_cast(unsigned, v);
    const u32x2s r = __builtin_amdgcn_permlane32_swap(x, x, false, false);
    return __builtin_bit_cast(float, (lane & 32) ? r[0] : r[1]);
}
#define MFMA32(a, b, c) __builtin_amdgcn_mfma_f32_32x32x16_bf16((a), (b), (c), 0, 0, 0)
__device__ __forceinline__ int crow(int reg, int h) { return (reg & 3) + 8 * (reg >> 2) + 4 * h; }
__device__ __forceinline__ bf16x8 pack8(const f32x16& x, int s) {
    u32x4 p; p.x = pk2(x[8 * s], x[8 * s + 1]); p.y = pk2(x[8 * s + 2], x[8 * s + 3]); p.z = pk2(x[8 * s + 4], x[8 * s + 5]); p.w = pk2(x[8 * s + 6], x[8 * s + 7]);
    return __builtin_bit_cast(bf16x8, p);
}
constexpr int MLA_KS = 400, MLA_VS = 320, MLA_VOFF = 64 * MLA_KS, MLA_BUF = 64 * (MLA_KS + MLA_VS);
__device__ __forceinline__ void mla_item(const Ctx& c, int qrow0, int nqv, int head, int keybase, int nk, int t_lo, int t_hi, int qpos0, float* part) {
    const bf16_t* Q = (const bf16_t*)(c.ws + WS_Q); const bf16_t* KVE = (const bf16_t*)(c.ws + WS_P); const bf16_t* KRK = (const bf16_t*)(c.ws + WS_KRK);
    bf16_t* YRAW = (bf16_t*)(c.ws + WS_YRAW);
    int tid_ = c.tid; asm volatile("" : "+v"(tid_));
    const int tid = tid_, lane = tid & 63, w = c.wave, r = lane & 31, h2 = lane >> 5;
    const int qi = w * 32 + r;
    const bool wactive = (w * 32 < nqv);
    const int tmax = (qpos0 + w * 32) >> 6;
    bf16x8 qf[12];
    { const bf16_t* qp = Q + (size_t)(qrow0 + (qi < nqv ? qi : nqv - 1)) * 768 + head * 192 + 8 * h2;
#pragma unroll
      for (int s = 0; s < 12; ++s) qf[s] = *(const bf16x8*)(qp + 16 * s); }
    f32x16 O[4];
#pragma unroll
    for (int cb = 0; cb < 4; ++cb)
#pragma unroll
        for (int i = 0; i < 16; ++i) O[cb][i] = 0.f;
    float mrun = -1e30f, lsum = 0.f;
    u32x4 stg[5];
    const bf16_t* pN = KVE + (size_t)(keybase + (tid >> 4)) * 1024 + head * 128 + 8 * (tid & 15);
    const bf16_t* pR = KRK + (size_t)(keybase + (tid >> 3)) * 64 + 8 * (tid & 7);
    LAS unsigned char* dN = c.lds + (tid >> 4) * MLA_KS + 16 * (tid & 15);
    LAS unsigned char* dR = c.lds + (tid >> 3) * MLA_KS + 256 + 16 * (tid & 7);
    LAS unsigned char* dV = c.lds + MLA_VOFF + (tid >> 4) * MLA_VS + 16 * (tid & 15);
#define MLA_PREFETCH(t) do { const bf16_t* a_ = pN + (size_t)(t) * 65536; stg[0] = *(const u32x4*)a_; stg[1] = *(const u32x4*)(a_ + 32768); stg[2] = *(const u32x4*)(a_ + 512); stg[3] = *(const u32x4*)(a_ + 32768 + 512); \
        stg[4] = *(const u32x4*)(pR + (size_t)(t) * 4096); } while (0)
#define MLA_COMMIT(o) do { *(LAS u32x4*)(dN + (o)) = stg[0]; *(LAS u32x4*)(dN + (o) + 32 * MLA_KS) = stg[1]; *(LAS u32x4*)(dV + (o)) = stg[2]; *(LAS u32x4*)(dV + (o) + 32 * MLA_VS) = stg[3]; *(LAS u32x4*)(dR + (o)) = stg[4]; } while (0)
    MLA_PREFETCH(t_lo);
    if (w >= 4) __builtin_amdgcn_s_setprio(2);
    const int q4 = (lane & 15) >> 2, p4 = lane & 3, blk = (lane >> 4) & 1;
    __syncthreads();
    MLA_COMMIT(0);
    __syncthreads();
    if (t_lo + 1 < t_hi) MLA_PREFETCH(t_lo + 1);
    for (int t = t_lo; t < t_hi; ++t) {
        const int bo = ((t - t_lo) & 1) * MLA_BUF;
        if (wactive && t <= tmax) {
            f32x16 sa[2];
#pragma unroll
            for (int kb = 0; kb < 2; ++kb)
#pragma unroll
                for (int i = 0; i < 16; ++i) sa[kb][i] = 0.f;
            { LAS unsigned char* kp = c.lds + bo + r * MLA_KS + 16 * h2;
#pragma unroll
              for (int s = 0; s < 12; ++s) {
                  const bf16x8 k0 = *(LAS bf16x8*)(kp + 32 * s), k1 = *(LAS bf16x8*)(kp + 32 * MLA_KS + 32 * s);
                  sa[0] = MFMA32(k0, qf[s], sa[0]); sa[1] = MFMA32(k1, qf[s], sa[1]);
                  if ((s & 3) == 3) __builtin_amdgcn_sched_barrier(0);
              } }
            if (64 * t + 63 >= nk) {
                asm volatile("" ::: "memory");
#pragma unroll
                for (int kb = 0; kb < 2; ++kb)
#pragma unroll
                    for (int i = 0; i < 16; ++i) if (64 * t + 32 * kb + crow(i, h2) >= nk) sa[kb][i] = -1e30f;
            }
            float mx = sa[0][0];
#pragma unroll
            for (int kb = 0; kb < 2; ++kb)
#pragma unroll
                for (int i = 0; i < 16; ++i) mx = fmaxf(mx, sa[kb][i]);
            mx = fmaxf(mx, xor32(mx, lane));
            const float mnew = fmaxf(mrun, mx), alpha = EX2(mrun - mnew);
            mrun = mnew;
            float ps = 0.f;
#pragma unroll
            for (int kb = 0; kb < 2; ++kb)
#pragma unroll
                for (int i = 0; i < 16; ++i) { const float p = EX2(sa[kb][i] - mnew); sa[kb][i] = p; ps += p; }
            lsum = lsum * alpha + ps;
            if (__ballot(alpha != 1.0f) != 0ull) {
#pragma unroll
                for (int cb = 0; cb < 4; ++cb)
#pragma unroll
                    for (int i = 0; i < 16; ++i) O[cb][i] *= alpha;
            }
#pragma unroll
            for (int kb = 0; kb < 2; ++kb)
#pragma unroll
                for (int s2 = 0; s2 < 2; ++s2) {
                    const bf16x8 pb = pack8(sa[kb], s2);
                    LAS unsigned char* vp = c.lds + bo + MLA_VOFF + (32 * kb + 16 * s2 + 4 * h2 + q4) * MLA_VS + 32 * blk + 8 * p4;
#pragma unroll
                    for (int cb = 0; cb < 4; ++cb) {
                        const s16x4 lo = __builtin_amdgcn_ds_read_tr16_b64_v4i16((LAS s16x4*)(vp + 64 * cb));
                        const s16x4 hi = __builtin_amdgcn_ds_read_tr16_b64_v4i16((LAS s16x4*)(vp + 64 * cb + 8 * MLA_VS));
                        const bf16x8 va = __builtin_shufflevector(lo, hi, 0, 1, 2, 3, 4, 5, 6, 7);
                        O[cb] = MFMA32(va, pb, O[cb]);
                    }
                    __builtin_amdgcn_sched_barrier(0);
                }
        }
        if (t + 1 < t_hi) MLA_COMMIT(MLA_BUF - bo);
        __syncthreads();
        if (t + 2 < t_hi) MLA_PREFETCH(t + 2);
    }
#undef MLA_PREFETCH
#undef MLA_COMMIT
    __builtin_amdgcn_s_setprio(0);
    if (!wactive) return;
    const float ltot = lsum + xor32(lsum, lane);
    if (part == nullptr) {
        const float inv = 1.0f / ltot;
        bf16_t* yp = YRAW + (size_t)(qrow0 + qi) * 1024 + 256 + head * 128 + 4 * h2;
#pragma unroll
        for (int cb = 0; cb < 4; ++cb)
#pragma unroll
            for (int g = 0; g < 4; ++g) { u32x2 o; o.x = pk2(O[cb][4 * g] * inv, O[cb][4 * g + 1] * inv); o.y = pk2(O[cb][4 * g + 2] * inv, O[cb][4 * g + 3] * inv);
                *(u32x2*)(yp + 32 * cb + 8 * g) = o; }
    } else if (qi < nqv) {
#pragma unroll
        for (int cb = 0; cb < 4; ++cb)
#pragma unroll
            for (int g = 0; g < 4; ++g) *(f32x4*)(part + qi * 128 + 32 * cb + 8 * g + 4 * h2) = (f32x4){O[cb][4 * g], O[cb][4 * g + 1], O[cb][4 * g + 2], O[cb][4 * g + 3]};
        if (h2 == 0) { part[2048 + qi] = mrun; part[2064 + qi] = ltot; }
    }
}

constexpr int SB_KS = 144, SB_VS = 192, SB_VOFF = 64 * SB_KS;
__device__ __forceinline__ void sb_item(const Ctx& c, int qrow0, int nqv, int head, int keybase, int t_lo, int t_hi, int qpos0, float* part) {
    const bf16_t* QC = (const bf16_t*)(c.ws + WS_QC); const bf16_t* KC = (const bf16_t*)(c.ws + WS_KC); const bf16_t* VC = (const bf16_t*)(c.ws + WS_VC);
    bf16_t* YRAW = (bf16_t*)(c.ws + WS_YRAW);
    int tid_ = c.tid; asm volatile("" : "+v"(tid_));
    const int tid = tid_, lane = tid & 63, w = c.wave, r = lane & 31, h2 = lane >> 5;
    const int qi = w * 32 + r;
    const bool wactive = (w * 32 < nqv);
    const int qpos = qpos0 + qi;
    const int tdiag = (qpos0 + w * 32) >> 6;
    bf16x8 qf[4];
    { const bf16_t* qp = QC + (size_t)(qrow0 + (qi < nqv ? qi : nqv - 1)) * 256 + head * 64 + 8 * h2;
#pragma unroll
      for (int s = 0; s < 4; ++s) qf[s] = *(const bf16x8*)(qp + 16 * s); }
    f32x16 O[2];
#pragma unroll
    for (int cb = 0; cb < 2; ++cb)
#pragma unroll
        for (int i = 0; i < 16; ++i) O[cb][i] = 0.f;
    float R = 1.0f;
    u32x4 stg[2];
    const size_t sboff = (size_t)(keybase + (tid >> 3)) * 256 + head * 64 + 8 * (tid & 7);
    const bf16_t* pK = KC + sboff; const bf16_t* pV = VC + sboff;
    LAS unsigned char* dK = c.lds + (tid >> 3) * SB_KS + 16 * (tid & 7);
    LAS unsigned char* dV = c.lds + SB_VOFF + (tid >> 3) * SB_VS + 16 * (tid & 7);
#define SB_PREFETCH(t) do { stg[0] = *(const u32x4*)(pK + (size_t)(t) * 16384); stg[1] = *(const u32x4*)(pV + (size_t)(t) * 16384); } while (0)
#define SB_COMMIT() do { *(LAS u32x4*)dK = stg[0]; *(LAS u32x4*)dV = stg[1]; } while (0)
    SB_PREFETCH(t_hi - 1);
    if (w >= 4) __builtin_amdgcn_s_setprio(2);
    const int q4 = (lane & 15) >> 2, p4 = lane & 3, blk = (lane >> 4) & 1;
    int alive = 1;
    for (int t = t_hi - 1; t >= t_lo; --t) {
        if (!__syncthreads_or(alive)) break;
        SB_COMMIT();
        __syncthreads();
        if (t - 1 >= t_lo) SB_PREFETCH(t - 1);
        if (wactive && t <= tdiag) {
            const bool diag = (t == tdiag);
#pragma unroll
            for (int kb = 1; kb >= 0; --kb) {
                f32x16 z;
#pragma unroll
                for (int i = 0; i < 16; ++i) z[i] = 0.f;
                LAS unsigned char* kp = c.lds + (32 * kb + r) * SB_KS + 16 * h2;
#pragma unroll
                for (int s = 0; s < 4; ++s) z = MFMA32(*(LAS bf16x8*)(kp + 32 * s), qf[s], z);
                float rr[16];
#pragma unroll
                for (int i = 0; i < 16; ++i) { const float e = EX2(fminf(z[i] * LOG2E, 64.0f)); z[i] = e; rr[i] = __builtin_amdgcn_rcpf(1.0f + e); }
                if (diag) {
                    asm volatile("" ::: "memory");
#pragma unroll
                    for (int i = 0; i < 16; ++i) if (64 * t + 32 * kb + crow(i, h2) >= qpos) { z[i] = 0.f; rr[i] = 1.0f; }
                }
                float seg[4], pt[4];
#pragma unroll
                for (int g = 0; g < 4; ++g) { rr[4 * g + 2] *= rr[4 * g + 3]; rr[4 * g + 1] *= rr[4 * g + 2]; rr[4 * g] *= rr[4 * g + 1]; seg[g] = rr[4 * g]; }
#pragma unroll
                for (int g = 0; g < 4; ++g) pt[g] = xor32(seg[g], lane);
                float off[4]; float acc = R;
#pragma unroll
                for (int g = 3; g >= 0; --g) { off[g] = h2 ? acc : acc * pt[g]; acc *= seg[g] * pt[g]; }
#pragma unroll
                for (int i = 0; i < 16; ++i) z[i] = z[i] * rr[i] * off[i >> 2];
                R = acc;
#pragma unroll
                for (int s2 = 0; s2 < 2; ++s2) {
                    const bf16x8 pb = pack8(z, s2);
                    LAS unsigned char* vp = c.lds + SB_VOFF + (32 * kb + 16 * s2 + 4 * h2 + q4) * SB_VS + 32 * blk + 8 * p4;
#pragma unroll
                    for (int cb = 0; cb < 2; ++cb) {
                        const s16x4 lo = __builtin_amdgcn_ds_read_tr16_b64_v4i16((LAS s16x4*)(vp + 64 * cb));
                        const s16x4 hi = __builtin_amdgcn_ds_read_tr16_b64_v4i16((LAS s16x4*)(vp + 64 * cb + 8 * SB_VS));
                        const bf16x8 va = __builtin_shufflevector(lo, hi, 0, 1, 2, 3, 4, 5, 6, 7);
                        O[cb] = MFMA32(va, pb, O[cb]);
                    }
                }
            }
        }
        alive = wactive && ((t - 1 > tdiag) || (__ballot(R != 0.f) != 0ull));
    }
#undef SB_PREFETCH
#undef SB_COMMIT
    __builtin_amdgcn_s_setprio(0);
    if (!wactive) return;
    if (part == nullptr) {
        bf16_t* yp = YRAW + (size_t)(qrow0 + qi) * 1024 + 768 + head * 64 + 4 * h2;
#pragma unroll
        for (int cb = 0; cb < 2; ++cb)
#pragma unroll
            for (int g = 0; g < 4; ++g) { u32x2 o; o.x = pk2(O[cb][4 * g], O[cb][4 * g + 1]); o.y = pk2(O[cb][4 * g + 2], O[cb][4 * g + 3]); *(u32x2*)(yp + 32 * cb + 8 * g) = o; }
    } else if (qi < nqv) {
#pragma unroll
        for (int cb = 0; cb < 2; ++cb)
#pragma unroll
            for (int g = 0; g < 4; ++g) *(f32x4*)(part + qi * 64 + 32 * cb + 8 * g + 4 * h2) = (f32x4){O[cb][4 * g], O[cb][4 * g + 1], O[cb][4 * g + 2], O[cb][4 * g + 3]};
        if (h2 == 0) part[1024 + qi] = R;
    }
}
constexpr int GM_VS = 576;
__device__ __forceinline__ void gmlp_item(const Ctx& c, int l, int row0, int n) {
    const bf16_t* U = (const bf16_t*)(c.ws + WS_U); const bf16_t* V = (const bf16_t*)(c.ws + WS_V); bf16_t* YRAW = (bf16_t*)(c.ws + WS_YRAW);
    const float* w_s = c.in[7] + (size_t)l * 4 * 128 * 128; const float* b_s = c.in[8] + (size_t)l * 4 * 128;
    int tid_ = c.tid; asm volatile("" : "+v"(tid_));
    const int tid = tid_, lane = tid & 63, w = c.wave, r = lane & 31, h2 = lane >> 5;
    __syncthreads();
#pragma unroll
    for (int k = 0; k < 8; ++k) { const int i = tid + 512 * k, row = i >> 5, ch = i & 31;
        const u32x4 v = row < n ? *(const u32x4*)(V + (size_t)(row0 + row) * 256 + 8 * ch) : (u32x4){0u, 0u, 0u, 0u};
        *(LAS u32x4*)(c.lds + row * GM_VS + 16 * ch) = v; }
    __syncthreads();
    const int g = w >> 1, ih = w & 1;
    if (n < 128 && ih == 1) return;
    const int q4 = (lane & 15) >> 2, p4 = lane & 3, blk = (lane >> 4) & 1;
#pragma unroll 1
    for (int ibl = 0; ibl < 2; ++ibl) {
        const int ib = 2 * ih + ibl;
        if (32 * ib >= n) break;
        const int i = 32 * ib + r; const bool ivalid = i < n; const int ic = ivalid ? i : n - 1;
        const int kmax = (n == 128) ? (ib < 2 ? 4 : 8) : 1;
        f32x16 acc[2];
#pragma unroll
        for (int db = 0; db < 2; ++db)
#pragma unroll
            for (int e = 0; e < 16; ++e) acc[db][e] = 0.f;
        const float* wp = w_s + ((size_t)g * 128 + ic) * 128 + 8 * h2;
        LAS unsigned char* vp = c.lds + (8 * h2 + q4) * GM_VS + (g * 64 + 16 * blk) * 2 + 8 * p4;
        for (int s = 0; s < kmax; ++s) {
            const f32x4 wa = *(const f32x4*)(wp + 16 * s), wb = *(const f32x4*)(wp + 16 * s + 4);
            u32x4 pw; pw.x = pk2(wa[0], wa[1]); pw.y = pk2(wa[2], wa[3]); pw.z = pk2(wb[0], wb[1]); pw.w = pk2(wb[2], wb[3]);
            const bf16x8 bfrag = __builtin_bit_cast(bf16x8, pw);
#pragma unroll
            for (int db = 0; db < 2; ++db) {
                const s16x4 lo = __builtin_amdgcn_ds_read_tr16_b64_v4i16((LAS s16x4*)(vp + 16 * s * GM_VS + 64 * db));
                const s16x4 hi = __builtin_amdgcn_ds_read_tr16_b64_v4i16((LAS s16x4*)(vp + (16 * s + 4) * GM_VS + 64 * db));
                const bf16x8 va = __builtin_shufflevector(lo, hi, 0, 1, 2, 3, 4, 5, 6, 7);
                acc[db] = MFMA32(va, bfrag, acc[db]);
            }
        }
        if (ivalid) {
            const float bb = b_s[g * 128 + i];
#pragma unroll
            for (int db = 0; db < 2; ++db)
#pragma unroll
                for (int gq = 0; gq < 4; ++gq) { const int d0 = g * 64 + 32 * db + 8 * gq + 4 * h2;
                    const u32x2 uu = *(const u32x2*)(U + (size_t)(row0 + i) * 256 + d0);
                    u32x2 o; o.x = pk2(bflo(uu.x) * (acc[db][4 * gq] + bb), bfhi(uu.x) * (acc[db][4 * gq + 1] + bb)); o.y = pk2(bflo(uu.y) * (acc[db][4 * gq + 2] + bb), bfhi(uu.y) * (acc[db][4 * gq + 3] + bb));
                    *(u32x2*)(YRAW + (size_t)(row0 + i) * 1024 + d0) = o; }
        }
    }
}

__device__ __forceinline__ void phase_attn(const Ctx& c, int l) {
    const int G = gridDim.x;
    float* PM = (float*)(c.ws + WS_PM); float* PS = (float*)(c.ws + WS_PS);
    for (int blk = blockIdx.x; blk < 256; blk += G) {
        const int it = (G == 256) ? ((blk & 7) * 32 + (blk >> 3)) : blk;
        const int b = it >> 4, h = (it >> 2) & 3, qq = it & 3;
        const int sb = it >> 5, sh = (it >> 3) & 3, sj = it & 7; const int t0 = (65 * sj) / NSPLIT, t1 = (65 * (sj + 1)) / NSPLIT;
#ifndef NO_MLA
#pragma unroll 1
        for (int k = 0; k < 3; ++k) {
            const int qb = k == 0 ? 7 - qq : qq;
            const bool pr = k < 2;
            mla_item(c, pr ? b * SEQ + qb * 256 : NP + sb * SSEQ, pr ? 256 : SSEQ, pr ? h : sh, pr ? b * SEQ : NP + sb * SKS, pr ? SEQ : SNK, pr ? 0 : t0, pr ? 4 * (qb + 1) : t1, pr ? qb * 256 : PAST,
                     pr ? nullptr : PM + (size_t)it * PM_STRIDE);
        }
#endif
#ifndef NO_SB
#pragma unroll 1
        for (int k = 0; k < 3; ++k) {
            const int qb = k == 0 ? 7 - qq : qq;
            const bool pr = k < 2;
            sb_item(c, pr ? b * SEQ + qb * 256 : NP + sb * SSEQ, pr ? 256 : SSEQ, pr ? h : sh, pr ? b * SEQ : NP + sb * SKS, pr ? 0 : t0, pr ? 4 * (qb + 1) : t1, pr ? qb * 256 : PAST,
                    pr ? nullptr : PS + (size_t)it * PS_STRIDE);
        }
#endif
#ifndef NO_GMLP
#pragma unroll 1
        for (int k = 0; k < 2; ++k) {
            if (k == 1 && it >= NSB) break;
            gmlp_item(c, l, k == 0 ? it * 128 : NP + it * SSEQ, k == 0 ? 128 : SSEQ);
        }
#endif
    }
}

__device__ __forceinline__ void p2_unpack(const u32x2 xa, const u32x4 xb, const u32x2 xc, float (&ya)[4], float (&yb)[8], float (&yc)[4]) {
    ya[0] = bflo(xa.x); ya[1] = bfhi(xa.x); ya[2] = bflo(xa.y); ya[3] = bfhi(xa.y);
    yb[0] = bflo(xb.x); yb[1] = bfhi(xb.x); yb[2] = bflo(xb.y); yb[3] = bfhi(xb.y); yb[4] = bflo(xb.z); yb[5] = bfhi(xb.z); yb[6] = bflo(xb.w); yb[7] = bfhi(xb.w);
    yc[0] = bflo(xc.x); yc[1] = bfhi(xc.x); yc[2] = bflo(xc.y); yc[3] = bfhi(xc.y);
}
__device__ __forceinline__ void p2_finish(const Ctx& c, int row, const float (&ya)[4], const float (&yb)[8], const float (&yc)[4], const float* gm, bf16_t* Y) {
    const int lane = c.lane;
    float sa = 0.f, sb = 0.f, sc2 = 0.f;
#pragma unroll
    for (int k = 0; k < 4; ++k) { sa += ya[k] * ya[k]; sc2 += yc[k] * yc[k]; }
#pragma unroll
    for (int k = 0; k < 8; ++k) sb += yb[k] * yb[k];
    const float ra = rsqrtf(wsum(sa) * (1.0f / 256.0f) + EPS), rb = rsqrtf(wsum(sb) * (1.0f / 512.0f) + EPS), rc = rsqrtf(wsum(sc2) * (1.0f / 256.0f) + EPS);
    bf16_t* yo = Y + (size_t)row * 1024;
    { const f32x4 g = *(const f32x4*)(gm + 4 * lane); u32x2 o; o.x = pk2(ya[0] * ra * g[0], ya[1] * ra * g[1]); o.y = pk2(ya[2] * ra * g[2], ya[3] * ra * g[3]); *(u32x2*)(yo + 4 * lane) = o; }
    { const f32x4 g0 = *(const f32x4*)(gm + 256 + 8 * lane), g1 = *(const f32x4*)(gm + 256 + 8 * lane + 4); u32x4 o;
      o.x = pk2(yb[0] * rb * g0[0], yb[1] * rb * g0[1]); o.y = pk2(yb[2] * rb * g0[2], yb[3] * rb * g0[3]); o.z = pk2(yb[4] * rb * g1[0], yb[5] * rb * g1[1]); o.w = pk2(yb[6] * rb * g1[2], yb[7] * rb * g1[3]);
      *(u32x4*)(yo + 256 + 8 * lane) = o; }
    { const f32x4 g = *(const f32x4*)(gm + 768 + 4 * lane); u32x2 o; o.x = pk2(yc[0] * rc * g[0], yc[1] * rc * g[1]); o.y = pk2(yc[2] * rc * g[2], yc[3] * rc * g[3]); *(u32x2*)(yo + 768 + 4 * lane) = o; }
}
__device__ __forceinline__ void phase_post2(const Ctx& c, int l) {
    const bf16_t* YRAW = (const bf16_t*)(c.ws + WS_YRAW); bf16_t* Y = (bf16_t*)(c.ws + WS_Y);
    const float* PM = (const float*)(c.ws + WS_PM); const float* PS = (const float*)(c.ws + WS_PS);
    const float* gm = c.in[14] + (size_t)l * 1024;
    const int lane = c.lane;
    const int W = gridDim.x * 8;
    for (int row = blockIdx.x * 8 + c.wave; row < NP; row += 2 * W) {
        const int row2 = row + W; const bool has2 = row2 < NP; const int rb = has2 ? row2 : row;
        const bf16_t* y0 = YRAW + (size_t)row * 1024; const bf16_t* y1 = YRAW + (size_t)rb * 1024;
        const u32x2 a0 = *(const u32x2*)(y0 + 4 * lane), a1 = *(const u32x2*)(y1 + 4 * lane);
        const u32x4 b0 = *(const u32x4*)(y0 + 256 + 8 * lane), b1 = *(const u32x4*)(y1 + 256 + 8 * lane);
        const u32x2 c0 = *(const u32x2*)(y0 + 768 + 4 * lane), c1 = *(const u32x2*)(y1 + 768 + 4 * lane);
        float ya[4], yb[8], yc[4];
        p2_unpack(a0, b0, c0, ya, yb, yc); p2_finish(c, row, ya, yb, yc, gm, Y);
        if (has2) { p2_unpack(a1, b1, c1, ya, yb, yc); p2_finish(c, row2, ya, yb, yc, gm, Y); }
    }
    for (int row = NP + blockIdx.x * 8 + c.wave; row < MT; row += W) {
        const bf16_t* yr = YRAW + (size_t)row * 1024;
        float ya[4], yb[8], yc[4];
        p2_unpack(*(const u32x2*)(yr + 4 * lane), *(const u32x4*)(yr + 256 + 8 * lane), *(const u32x2*)(yr + 768 + 4 * lane), ya, yb, yc);
        if (row < NP + NS) {
            const int srow = row - NP, b = srow >> 4, s = srow & 15;
            { const int head = lane >> 4, cc = (8 * lane) & 127; const float* base = PM + (size_t)((b * 4 + head) * NSPLIT) * PM_STRIDE;
              float mm = -1e30f;
#pragma unroll
              for (int j = 0; j < NSPLIT; ++j) mm = fmaxf(mm, base[j * PM_STRIDE + 2048 + s]);
              float den = 0.f;
#pragma unroll
              for (int k = 0; k < 8; ++k) yb[k] = 0.f;
#pragma unroll
              for (int j = 0; j < NSPLIT; ++j) { const float sc = exp2f(base[j * PM_STRIDE + 2048 + s] - mm); den += sc * base[j * PM_STRIDE + 2064 + s];
                  const f32x4 o0 = *(const f32x4*)(base + j * PM_STRIDE + s * 128 + cc), o1 = *(const f32x4*)(base + j * PM_STRIDE + s * 128 + cc + 4);
#pragma unroll
                  for (int k = 0; k < 4; ++k) { yb[k] += sc * o0[k]; yb[4 + k] += sc * o1[k]; } }
              const float inv = 1.0f / den;
#pragma unroll
              for (int k = 0; k < 8; ++k) yb[k] *= inv; }
            { const int head = lane >> 4, cc = (4 * lane) & 63; const float* base = PS + (size_t)((b * 4 + head) * NSPLIT) * PS_STRIDE;
              float sc = 1.0f;
#pragma unroll
              for (int k = 0; k < 4; ++k) yc[k] = 0.f;
#pragma unroll
              for (int j = NSPLIT - 1; j >= 0; --j) { const f32x4 o = *(const f32x4*)(base + j * PS_STRIDE + s * 64 + cc);
#pragma unroll
                  for (int k = 0; k < 4; ++k) yc[k] += sc * o[k];
                  sc *= base[j * PS_STRIDE + 1024 + s]; } }
        }
        p2_finish(c, row, ya, yb, yc, gm, Y);
    }
}

__device__ __forceinline__ void phase_ln(const Ctx& c, const float* g, const float* b, const float* preb, bool final, int nsplit) {
    float* XF = (float*)(c.ws + WS_XF); bf16_t* XB = (bf16_t*)(c.ws + WS_XB); const bf16_t* TB = (const bf16_t*)(c.ws + WS_XF);
    const int lane = c.lane;
    f32x4 gg[4], bb[4];
#pragma unroll
    for (int k = 0; k < 4; ++k) { gg[k] = *(const f32x4*)(g + 256 * k + 4 * lane); bb[k] = *(const f32x4*)(b + 256 * k + 4 * lane); }
    constexpr int RW = 1;
    for (int base = (blockIdx.x * 8 + c.wave) * RW; base < MT; base += gridDim.x * 8 * RW) {
        f32x4 x[RW][4];
        if (base < NP) {
#pragma unroll
            for (int r = 0; r < RW; ++r)
#pragma unroll
                for (int k = 0; k < 4; ++k) { const u32x2 w = __builtin_nontemporal_load((const u32x2*)(TB + (size_t)(base + r) * 1024 + 256 * k + 4 * lane)); const f32x2v lo = unpkh(w.x), hi = unpkh(w.y); x[r][k] = (f32x4){lo.x, lo.y, hi.x, hi.y}; }
        } else {
#pragma unroll
            for (int r = 0; r < RW; ++r)
#pragma unroll
                for (int k = 0; k < 4; ++k) x[r][k] = *(const f32x4*)(XF + (size_t)(base + r) * 1024 + 256 * k + 4 * lane);
        }
        if (base >= NP) {
            const float* PART = (const float*)(c.ws + WS_PS32);
            for (int s = 0; s < nsplit; ++s)
#pragma unroll
                for (int r = 0; r < RW; ++r)
#pragma unroll
                    for (int k = 0; k < 4; ++k) x[r][k] += *(const f32x4*)(PART + ((size_t)s * 256 + (base - NP + r)) * 1024 + 256 * k + 4 * lane);
        }
#pragma unroll
        for (int r = 0; r < RW; ++r) {
            const int row = base + r; float* xr = XF + (size_t)row * 1024;
            float s = 0.f;
#pragma unroll
            for (int k = 0; k < 4; ++k) s += x[r][k][0] + x[r][k][1] + x[r][k][2] + x[r][k][3];
            const float mu = wsum(s) * (1.0f / 1024.0f);
            float v = 0.f;
#pragma unroll
            for (int k = 0; k < 4; ++k) { x[r][k] -= mu; v += x[r][k][0] * x[r][k][0] + x[r][k][1] * x[r][k][1] + x[r][k][2] * x[r][k][2] + x[r][k][3] * x[r][k][3]; }
            const float rs = rsqrtf(wsum(v) * (1.0f / 1024.0f) + EPS);
#pragma unroll
            for (int k = 0; k < 4; ++k) x[r][k] = x[r][k] * rs * gg[k] + bb[k];
            if (!final) {
#pragma unroll
                for (int k = 0; k < 4; ++k) { u32x2 o; o.x = pk2(x[r][k][0], x[r][k][1]); o.y = pk2(x[r][k][2], x[r][k][3]); *(u32x2*)(XB + (size_t)row * 1024 + 256 * k + 4 * lane) = o;
                    if (row >= NP) { const f32x4 pb = preb ? *(const f32x4*)(preb + 256 * k + 4 * lane) : (f32x4){0.f, 0.f, 0.f, 0.f};
                        *(f32x4*)(xr + 256 * k + 4 * lane) = (f32x4){bflo(o.x), bfhi(o.x), bflo(o.y), bfhi(o.y)} * ALPHA + pb; } }
            } else if (row < NP + NS) {
                float* op = row < NP ? c.out + O_YP + (size_t)row * 1024 : c.out + O_YS + (size_t)(row - NP) * 1024;
#pragma unroll
                for (int k = 0; k < 4; ++k) __builtin_nontemporal_store(x[r][k], (f32x4*)(op + 256 * k + 4 * lane));
            }
        }
    }
}

__global__ void __launch_bounds__(512) fwd_mega(Params p) {
    extern __shared__ __attribute__((aligned(16))) unsigned char smem[];
    cg::this_grid().sync();
    Ctx c;
#pragma unroll
    for (int i = 0; i < 24; ++i) c.in[i] = p.in[i];
    c.out = p.out; c.ws = p.ws;
    c.tid = threadIdx.x; c.lane = c.tid & 63; c.wave = __builtin_amdgcn_readfirstlane(c.tid >> 6);
    c.lds = (LAS unsigned char*)smem; c.sm = (float*)smem;
#define RL() do { int t_ = threadIdx.x; asm volatile("" : "+v"(t_)); c.tid = t_; c.lane = t_ & 63; c.wave = __builtin_amdgcn_readfirstlane(t_ >> 6); } while (0)
    const bf16_t* XB = (const bf16_t*)(c.ws + WS_XB);
    if (threadIdx.x < 4) ((LAS unsigned*)(smem + 131072))[threadIdx.x] = 0u;
    __syncthreads();
    const XcdBarrier xbar = xcd_barrier_post((unsigned*)(c.ws + WS_BAR), (volatile LAS unsigned*)(smem + 131072));
#ifndef NO_PREP
    RL(); phase_prep(c);
#endif
    xcd_barrier(xbar);
    for (int l = 0; l < DEPTH; ++l) {
#if !defined(PHM) || (PHM & 1)
        { EpiBf16 E{(bf16_t*)(c.ws + WS_P), 2048}; run_gemm(c, XB, (const bf16_t*)(c.ws + WS_W1T + l * SZ_W1T), NP, 2048, 1024, E); }
        __syncthreads();
        { EpiPart E{(float*)(c.ws + WS_PS32), 2048, NP, (size_t)256 * 2048}; run_gemm_split(c, XB, (const bf16_t*)(c.ws + WS_W1T + l * SZ_W1T), NP / 256, 2048, 1024, 256, E); }
        if (l > 0) { RL(); cache_convert(c, l, 32, 3, 4); }
#endif
        xcd_barrier(xbar);
#ifndef NO_POST1
        RL(); phase_post1(c, l);
#endif
        xcd_barrier(xbar);
#if !defined(PHM) || (PHM & 2)
        { EpiQ E{(bf16_t*)(c.ws + WS_Q), (const float*)(c.ws + WS_TAB)}; run_gemm(c, (const bf16_t*)(c.ws + WS_CQN), (const bf16_t*)(c.ws + WS_WUQT + l * SZ_WUQT), MT, 768, 384, E); }
#endif
        __syncthreads();
#if !defined(PHM) || (PHM & 4)
        { EpiBf16 E{(bf16_t*)(c.ws + WS_P), 1024}; run_gemm(c, (const bf16_t*)(c.ws + WS_CKVK), (const bf16_t*)(c.ws + WS_WKVT + l * SZ_WKVT), KR, 1024, 256, E, 0, true); }
#endif
        xcd_barrier(xbar);
#ifndef NO_ATTN
        RL(); phase_attn(c, l);
#endif
        xcd_barrier(xbar);
#ifndef NO_POST2
        RL(); phase_post2(c, l);
#endif
        xcd_barrier(xbar);
#if !defined(PHM) || (PHM & 8)
        { EpiRes E{(bf16_t*)(c.ws + WS_XF), XB, nullptr}; run_gemm(c, (const bf16_t*)(c.ws + WS_Y), (const bf16_t*)(c.ws + WS_WOUTT + l * SZ_WOUTT), NP, 1024, 1024, E); }
        __syncthreads();
        { EpiPart E{(float*)(c.ws + WS_PS32), 1024, NP, (size_t)256 * 1024}; run_gemm_split(c, (const bf16_t*)(c.ws + WS_Y), (const bf16_t*)(c.ws + WS_WOUTT + l * SZ_WOUTT), NP / 256, 1024, 1024, 256, E); }
        if (l + 1 < DEPTH) { RL(); cache_convert(c, l + 1, 16, 0, 4); }
#endif
        xcd_barrier(xbar);
#if !defined(PHM) || (PHM & 64)
        RL(); phase_ln(c, c.in[16] + l * 1024, c.in[17] + l * 1024, c.in[21] + l * 1024, false, 4);
#endif
        xcd_barrier(xbar);
#if !defined(PHM) || (PHM & 16)
        { EpiRelu2 E{(bf16_t*)(c.ws + WS_H), HLD, c.in[19] + l * 4096}; run_gemm(c, XB, (const bf16_t*)(c.ws + WS_WUPT + l * SZ_WUPT), MT, 4096, 1024, E); }
        if (l + 1 < DEPTH) { RL(); cache_convert(c, l + 1, 16, 1, 4); }
#endif
        xcd_barrier(xbar);
#if !defined(PHM) || (PHM & 32)
        { EpiRes E{(bf16_t*)(c.ws + WS_XF), XB, c.in[21] + l * 1024}; run_gemm(c, (const bf16_t*)(c.ws + WS_H), (const bf16_t*)(c.ws + WS_WDNT + l * SZ_WDNT), NP, 1024, 4096, E, HLD, false, true); }
        __syncthreads();
        { EpiPart E{(float*)(c.ws + WS_PS32), 1024, NP, (size_t)256 * 1024}; run_gemm_split(c, (const bf16_t*)(c.ws + WS_H), (const bf16_t*)(c.ws + WS_WDNT + l * SZ_WDNT), NP / 256, 1024, 4096, 512, E, HLD); }
        if (l + 1 < DEPTH) { RL(); cache_convert(c, l + 1, 32, 2, 4); }
#endif
        xcd_barrier(xbar);
#if !defined(PHM) || (PHM & 64)
        RL(); phase_ln(c, c.in[22] + l * 1024, c.in[23] + l * 1024, nullptr, l == DEPTH - 1, 8);
#endif
        if (l + 1 < DEPTH) xcd_barrier(xbar);
    }
}

constexpr int LDS_BYTES = 131072 + 16;
extern "C" void kernel_launch(void* const* d_in, const int* in_sizes, int n_in, void* d_out, int out_size, void* d_ws, size_t ws_size, hipStream_t stream) {
    static int grid = 0;
    if (grid == 0) {
        if (n_in != 24 || ws_size < WS_END) { fprintf(stderr, "kernel_launch: n_in %d ws %zu need %zu\n", n_in, ws_size, (size_t)WS_END); grid = -1; return; }
        int dev = 0, cus = 0, per_cu = 0;
        hipGetDevice(&dev); hipDeviceGetAttribute(&cus, hipDeviceAttributeMultiprocessorCount, dev);
        hipFuncSetAttribute((const void*)fwd_mega, hipFuncAttributeMaxDynamicSharedMemorySize, LDS_BYTES);
        hipOccupancyMaxActiveBlocksPerMultiprocessor(&per_cu, (const void*)fwd_mega, 512, LDS_BYTES);
        if (per_cu < 1) per_cu = 1;
        grid = cus * per_cu; if (grid > 256) grid = 256;
        (void)hipGetLastError();
    }
    if (grid < 0) return;
    if (hipMemsetAsync((char*)d_ws + WS_BAR, 0, 16384, stream) != hipSuccess) { fprintf(stderr, "memset failed\n"); return; }
    Params p{};
    for (int i = 0; i < 24; ++i) p.in[i] = (const float*)d_in[i];
    p.out = (float*)d_out; p.ws = (unsigned char*)d_ws;
    void* args[] = {&p};
    hipError_t e = hipLaunchCooperativeKernel((const void*)fwd_mega, dim3(grid), dim3(512), args, LDS_BYTES, stream);
    if (e != hipSuccess) fprintf(stderr, "cooperative launch failed: %s (grid %d)\n", hipGetErrorString(e), grid);
}
```

```cpp
#include <hip/hip_runtime.h>
#include <hip/hip_cooperative_groups.h>
#include <cstdio>
#include <cstdint>
namespace cg = cooperative_groups;
namespace pg8 {
#define PG8_LAS __attribute__((address_space(3)))
typedef unsigned short bf16_t;
typedef short bf16x8 __attribute__((ext_vector_type(8)));
typedef float f32x4 __attribute__((ext_vector_type(4)));
typedef unsigned u32x4 __attribute__((ext_vector_type(4)));
constexpr int BM = 256, BK = 64, HALF = 128, HTB = HALF * BK * 2  , STAGE_BYTES = 8 * HTB, NXCD = 8, WGM = 8;

__host__ __device__ __forceinline__ int lds_byte(int r, int c) { const int st = (r >> 4) * 2 + (c >> 5), rr = r & 15, cc = c & 31, ob = rr * 64 + cc * 2; return st * 1024 + (ob ^ (((ob >> 9) & 1) << 5)); }
__host__ __device__ __forceinline__ void stage_rc(int b, int& R, int& C) { const int st = b / 1024, sb = b % 1024, swz = sb ^ (((sb >> 9) & 1) << 5); R = (st >> 1) * 16 + swz / 64; C = (st & 1) * 32 + (swz % 64) / 2; }
__host__ __device__ __forceinline__ int perm32(int rho) { const int n = rho >> 4, i = rho & 15; return 8 * (i >> 2) + 4 * n + (i & 3); }

struct Unit { int pm, pn, ks; };
struct Gemm { const bf16_t* A; const bf16_t* Bt; int M, N, K, ld; };

struct StaticOrder {
    int nM, nN, nwg, G, c;
    __host__ __device__ void init(int M, int N, int G_, int c_) { nM = M / BM; nN = N / BM; nwg = nM * nN; G = G_; c = c_; }
    __host__ __device__ bool next(int i, Unit& u) const {
        const long L = (long)i * G + c; if (L >= nwg) return false;
        int wgid = (int)L; { const int q = nwg / NXCD, r = nwg % NXCD, xcd = wgid % NXCD, off = wgid / NXCD; wgid = (xcd < r ? xcd * (q + 1) : r * (q + 1) + (xcd - r) * q) + off; }
        const int nig = WGM * nN, gid = wgid / nig, fm = gid * WGM, gsz = (nM - fm) < WGM ? (nM - fm) : WGM;
        u.pm = fm + ((wgid % nig) % gsz); u.pn = (wgid % nig) / gsz; u.ks = 0; return true;
    }
    __device__ __forceinline__ void a_ready(const Unit&) const {}
    __device__ __forceinline__ void done(const Unit&) const {}
};


struct SplitOrder {
    int pm, nN, nS, G, c;
    __device__ __forceinline__ bool next(int i, Unit& u) const { const int L = i * G + c; if (L >= nN * nS) return false; u.pm = pm; u.pn = L % nN; u.ks = L / nN; return true; }
    __device__ __forceinline__ void a_ready(const Unit&) const {}
    __device__ __forceinline__ void done(const Unit&) const {}
};
template <class Epi, class Sched>
__device__ __forceinline__ void gemm_phase(PG8_LAS unsigned char* lds, const Gemm g, const Sched& S, const Epi& E) {
    int tid_ = threadIdx.x; asm volatile("" : "+v"(tid_));
    const int tid = tid_, wid = __builtin_amdgcn_readfirstlane(tid >> 6), lane = tid & 63, wr = wid >> 2, wc = wid & 3, fr = lane & 15, fq = lane >> 4;
    const int K = g.K, nt = K / BK;
    unsigned voffA[2], voffB[2];
#pragma unroll
    for (int i = 0; i < 2; ++i) { int R, C; stage_rc(tid * 16 + i * 8192, R, C); const int Rb = Epi::PERM ? ((R & ~31) + perm32(R & 31)) : R;
        voffA[i] = (unsigned)(R * g.ld + C) * 2u; voffB[i] = (unsigned)(Rb * g.ld + C) * 2u; }
    const size_t kstep = (size_t)(BK * 2);
    const size_t hstep = (size_t)HALF * g.ld * 2;
    const size_t tstep = 2 * hstep;
    const unsigned ldsw = (unsigned)wid * 1024u;
    const int aoff = lds_byte(wr * 64 + fr, fq * 8), boff = lds_byte(wc * 32 + fr, fq * 8);
#define PG8_SA(b, h) (((b) * 2 + (h)) * HTB)
#define PG8_SB(b, h) ((4 + (b) * 2 + (h)) * HTB)
#define PG8_STAGE(bufoff, gbase, voff) do { _Pragma("unroll") for (int _i = 0; _i < 2; ++_i) \
        __builtin_amdgcn_global_load_lds((const unsigned*)((const char*)(gbase) + (voff)[_i]), (PG8_LAS unsigned*)(lds + (bufoff) + ldsw + _i * 8192), 16, 0, 0); } while (0)
#define PG8_LDA(dst, b, h) do { _Pragma("unroll") for (int m = 0; m < 4; ++m) _Pragma("unroll") for (int k = 0; k < 2; ++k) dst[m][k] = *(const PG8_LAS bf16x8*)(lds + PG8_SA(b, h) + aoff + m * 2048 + k * 1024); } while (0)
#define PG8_LDB(dst, b, h) do { _Pragma("unroll") for (int n = 0; n < 2; ++n) _Pragma("unroll") for (int k = 0; k < 2; ++k) dst[n][k] = *(const PG8_LAS bf16x8*)(lds + PG8_SB(b, h) + boff + n * 2048 + k * 1024); } while (0)
#define PG8_MMA(ai, bj, At, Bt) do { __builtin_amdgcn_s_setprio(1); _Pragma("unroll") for (int m = 0; m < 4; ++m) _Pragma("unroll") for (int n = 0; n < 2; ++n) _Pragma("unroll") for (int k = 0; k < 2; ++k) \
        acc[ai][bj][m][n] = __builtin_amdgcn_mfma_f32_16x16x32_bf16(Bt[n][k], At[m][k], acc[ai][bj][m][n], 0, 0, 0); __builtin_amdgcn_s_setprio(0); } while (0)
#define PG8_WAIT_V(n) asm volatile("s_waitcnt vmcnt(" #n ")" ::: "memory")
#define PG8_WAIT_L(n) asm volatile("s_waitcnt lgkmcnt(" #n ")" ::: "memory")
#define PG8_BAR __builtin_amdgcn_s_barrier()
#define PG8_SCHED __builtin_amdgcn_sched_barrier(0)
    Unit cur, nxt; int ui = 0;
    if (!S.next(0, cur)) return;
    f32x4 acc[2][2][4][2];
#pragma unroll
    for (int a = 0; a < 2; ++a)
#pragma unroll
        for (int b = 0; b < 2; ++b)
#pragma unroll
            for (int m = 0; m < 4; ++m)
#pragma unroll
                for (int n = 0; n < 2; ++n) acc[a][b][m][n] = (f32x4){0.f, 0.f, 0.f, 0.f};
    bf16x8 At[4][2], B0[2][2], B1[2][2];
    const size_t sstep = (size_t)K * 2;
    const char* cA = (const char*)g.A + (size_t)cur.pm * tstep + (size_t)cur.ks * sstep; const char* cB = (const char*)g.Bt + (size_t)cur.pn * tstep + (size_t)cur.ks * sstep;
    S.a_ready(cur);
    PG8_STAGE(PG8_SB(0, 0), cB, voffB); PG8_STAGE(PG8_SB(0, 1), cB + hstep, voffB); PG8_STAGE(PG8_SA(0, 0), cA, voffA); PG8_STAGE(PG8_SA(0, 1), cA + hstep, voffA);
    if (wr == 1) PG8_BAR;
    PG8_WAIT_V(2); PG8_BAR;
    PG8_STAGE(PG8_SB(1, 0), cB + kstep, voffB); PG8_STAGE(PG8_SA(1, 0), cA + kstep, voffA); PG8_STAGE(PG8_SB(1, 1), cB + hstep + kstep, voffB);
    PG8_WAIT_V(6); PG8_BAR;
    for (;;) {
        const bool has_next = S.next(ui + 1, nxt);
        const char* nA = has_next ? (const char*)g.A + (size_t)nxt.pm * tstep + (size_t)nxt.ks * sstep : cA; const char* nB = has_next ? (const char*)g.Bt + (size_t)nxt.pn * tstep + (size_t)nxt.ks * sstep : cB;
        for (int t = 0; t < nt; t += 2) {
            const bool last = (t == nt - 2);
            const char* a1 = cA + (size_t)(t + 1) * kstep;
            const char* a2 = last ? nA : cA + (size_t)(t + 2) * kstep; const char* b2 = last ? nB : cB + (size_t)(t + 2) * kstep;
            const char* a3 = a2 + kstep; const char* b3 = b2 + kstep;
            if (last && has_next) S.a_ready(nxt);
            PG8_LDB(B0, 0, 0); PG8_LDB(B1, 0, 1); PG8_SCHED; PG8_LDA(At, 0, 0); PG8_STAGE(PG8_SA(1, 1), a1 + hstep, voffA);
            PG8_WAIT_V(8); PG8_WAIT_L(0); PG8_BAR; PG8_MMA(0, 0, At, B0); PG8_MMA(0, 1, At, B1); PG8_BAR; PG8_SCHED;
            PG8_LDA(At, 0, 1); PG8_STAGE(PG8_SB(0, 0), b2, voffB); PG8_STAGE(PG8_SB(0, 1), b2 + hstep, voffB); PG8_STAGE(PG8_SA(0, 0), a2, voffA);
            PG8_WAIT_V(8); PG8_WAIT_L(0); PG8_BAR; PG8_MMA(1, 0, At, B0); PG8_MMA(1, 1, At, B1); PG8_BAR; PG8_SCHED;
            PG8_LDB(B0, 1, 0); PG8_LDB(B1, 1, 1); PG8_SCHED; PG8_LDA(At, 1, 0); PG8_STAGE(PG8_SA(0, 1), a2 + hstep, voffA);
            PG8_WAIT_V(8); PG8_WAIT_L(0); PG8_BAR; PG8_MMA(0, 0, At, B0); PG8_MMA(0, 1, At, B1); PG8_BAR; PG8_SCHED;
            PG8_LDA(At, 1, 1); PG8_STAGE(PG8_SB(1, 0), b3, voffB); PG8_STAGE(PG8_SB(1, 1), b3 + hstep, voffB); PG8_STAGE(PG8_SA(1, 0), a3, voffA);
            PG8_WAIT_V(8); PG8_WAIT_L(0); PG8_BAR; PG8_MMA(1, 0, At, B0); PG8_MMA(1, 1, At, B1); PG8_BAR; PG8_SCHED;
        }
        if constexpr (!Epi::AFTER_DRAIN) { E(acc, cur, wr, wc, fr, fq); S.done(cur); }
        if (!has_next) break;
#pragma unroll
        for (int a = 0; a < 2; ++a)
#pragma unroll
            for (int b = 0; b < 2; ++b)
#pragma unroll
                for (int m = 0; m < 4; ++m)
#pragma unroll
                    for (int n = 0; n < 2; ++n) acc[a][b][m][n] = (f32x4){0.f, 0.f, 0.f, 0.f};
        cur = nxt; cA = nA; cB = nB; ++ui;
    }
    PG8_WAIT_V(0);
    if (wr == 0) PG8_BAR;
    PG8_BAR;
    if constexpr (Epi::AFTER_DRAIN) { E.fused(acc, cur, wr, wc, fr, fq, lds, wid, lane); S.done(cur); }
#undef PG8_SA
#undef PG8_SB
#undef PG8_STAGE
#undef PG8_LDA
#undef PG8_LDB
#undef PG8_MMA
#undef PG8_WAIT_V
#undef PG8_WAIT_L
#undef PG8_BAR
#undef PG8_SCHED
}
}

using pg8::bf16_t; using pg8::bf16x8; using pg8::f32x4; using pg8::u32x4;
#define LAS __attribute__((address_space(3)))
typedef short s16x4 __attribute__((ext_vector_type(4)));
typedef float f32x16 __attribute__((ext_vector_type(16)));
typedef float f32x2v __attribute__((ext_vector_type(2)));
typedef __bf16 bf16x2v __attribute__((ext_vector_type(2)));
typedef unsigned u32x2 __attribute__((ext_vector_type(2)));
typedef unsigned u32x3 __attribute__((ext_vector_type(3)));

constexpr int DM = 1024, NPB = 16, SEQ = 2048, DEPTH = 4, NSB = 8, SSEQ = 16, PAST = 4096;
constexpr int NP = NPB * SEQ;
constexpr int NS = NSB * SSEQ;
constexpr int MT = NP + 256;
constexpr int SKS = 4160;
constexpr int SNK = PAST + SSEQ;
constexpr int KR = NP + NSB * SKS;
constexpr int WIN = 1984, DFF = 4096;
constexpr float EPS = 1e-5f;
constexpr float ALPHA = 1.6817928305074290f;
constexpr float LOG2E = 1.4426950408889634f;
constexpr float MLA_QS = 0.07216878364870322f * 1.4426950408889634f;
constexpr int NSPLIT = 8;
constexpr int NTAB = SEQ + SSEQ;

constexpr size_t O_YP = 0, O_YS = 33554432, O_CKVP = 33685504, O_KRP = 67239936, O_KP = 75628544, O_VP = 109182976,
                 O_CKVS = 142737408, O_KRS = 142868480, O_KS = 142901248, O_VS = 143032320, O_GV = 143163392;

constexpr size_t al256(size_t x) { return (x + 255) & ~(size_t)255; }
constexpr size_t WS_W1T = 0;
constexpr size_t SZ_W1T = (size_t)2048 * 1024 * 2;
constexpr size_t WS_WUQT = WS_W1T + DEPTH * SZ_W1T;
constexpr size_t SZ_WUQT = (size_t)768 * 384 * 2;
constexpr size_t WS_WKVT = WS_WUQT + DEPTH * SZ_WUQT;
constexpr size_t SZ_WKVT = (size_t)1024 * 256 * 2;
constexpr size_t WS_WOUTT = WS_WKVT + DEPTH * SZ_WKVT;
constexpr size_t SZ_WOUTT = (size_t)1024 * 1024 * 2;
constexpr size_t WS_WUPT = WS_WOUTT + DEPTH * SZ_WOUTT;
constexpr size_t SZ_WUPT = (size_t)4096 * 1024 * 2;
constexpr size_t WS_WDNT = WS_WUPT + DEPTH * SZ_WUPT;
constexpr int HLD = 4096 + 64;
constexpr size_t SZ_WDNT = (size_t)1024 * HLD * 2;
constexpr size_t WS_TAB = WS_WDNT + DEPTH * SZ_WDNT;
constexpr size_t WS_XF = al256(WS_TAB + (size_t)NTAB * 32 * 8);
constexpr size_t WS_XB = WS_XF + (size_t)MT * 1024 * 4;
constexpr size_t WS_CKVK = WS_XB + (size_t)MT * 1024 * 2;
constexpr size_t WS_KRK = WS_CKVK + (size_t)KR * 256 * 2;
constexpr size_t WS_KC = WS_KRK + (size_t)KR * 64 * 2;
constexpr size_t WS_VC = WS_KC + (size_t)KR * 256 * 2;
constexpr int PM_STRIDE = 16 * 128 + 32, PS_STRIDE = 16 * 64 + 16;
constexpr size_t WS_PM = WS_VC + (size_t)KR * 256 * 2;
constexpr size_t WS_PS = al256(WS_PM + (size_t)NSB * 4 * NSPLIT * PM_STRIDE * 4);
constexpr size_t WS_R = al256(WS_PS + (size_t)NSB * 4 * NSPLIT * PS_STRIDE * 4);
constexpr size_t WS_P = WS_R;
constexpr size_t WS_U = WS_P + (size_t)MT * 2048 * 2;
constexpr size_t WS_V = WS_U + (size_t)MT * 256 * 2;
constexpr size_t WS_CQN = WS_V + (size_t)MT * 256 * 2;
constexpr size_t WS_Q = WS_CQN + (size_t)MT * 384 * 2;
constexpr size_t WS_QC = WS_Q + (size_t)MT * 768 * 2;
constexpr size_t WS_YRAW = WS_QC + (size_t)MT * 256 * 2;
constexpr size_t WS_PS32 = WS_YRAW + (size_t)MT * 1024 * 2;
constexpr size_t WS_BAR = WS_PS32 + (size_t)8 * 256 * 1024 * 4;
constexpr size_t WS_END = WS_BAR + 16384;
constexpr size_t WS_Y = WS_Q;
constexpr size_t WS_H = WS_R;
static_assert((size_t)KR * 1024 * 2 == (size_t)MT * 2048 * 2, "KVEXP aliases P exactly");
static_assert(WS_R + (size_t)MT * HLD * 2 <= WS_BAR, "H fits in the aliased region");

struct Params { const float* in[24]; float* out; unsigned char* ws; };

struct Ctx {
    const float* in[24]; float* out; unsigned char* ws;
    int tid, lane, wave;
    LAS unsigned char* lds;
    float* sm;
};

__device__ __forceinline__ unsigned pk2(float a, float b) { f32x2v v = {a, b}; bf16x2v r = __builtin_convertvector(v, bf16x2v); return __builtin_bit_cast(unsigned, r); }
typedef _Float16 f16x2v __attribute__((ext_vector_type(2)));
__device__ __forceinline__ unsigned pkh(float a, float b) { f32x2v v = {a, b}; f16x2v r = __builtin_convertvector(v, f16x2v); return __builtin_bit_cast(unsigned, r); }
__device__ __forceinline__ f32x2v unpkh(unsigned u) { return __builtin_convertvector(__builtin_bit_cast(f16x2v, u), f32x2v); }
__device__ __forceinline__ float bflo(unsigned u) { return __uint_as_float(u << 16); }
__device__ __forceinline__ float bfhi(unsigned u) { return __uint_as_float(u & 0xffff0000u); }
__device__ __forceinline__ bf16_t f2bf(float a) { return (bf16_t)(pk2(a, 0.f) & 0xffffu); }
__device__ __forceinline__ float bf2f(bf16_t v) { return __uint_as_float((unsigned)v << 16); }
__device__ __forceinline__ float gelu_tanh(float x) {
    const float y = 0.7978845608028654f * (x + 0.044715f * x * x * x);
    const float e = __expf(2.0f * y);
    const float t = 1.0f - 2.0f * __builtin_amdgcn_rcpf(1.0f + e);
    return 0.5f * x * (1.0f + t);
}
#define DPPF(v, ctrl, rmask) __builtin_bit_cast(float, __builtin_amdgcn_update_dpp(0, __builtin_bit_cast(int, (v)), (ctrl), (rmask), 0xf, true))
__device__ __forceinline__ float gsum16(float v) {
    v += DPPF(v, 0xB1, 0xf); v += DPPF(v, 0x4E, 0xf); v += DPPF(v, 0x141, 0xf); v += DPPF(v, 0x140, 0xf);
    return v;
}
__device__ __forceinline__ float wsum(float v) {
    v = gsum16(v);
    v += DPPF(v, 0x142, 0xa); v += DPPF(v, 0x143, 0xc);
    return __builtin_bit_cast(float, __builtin_amdgcn_readlane(__builtin_bit_cast(int, v), 63));
}
__device__ __forceinline__ int pos_index(int row) { return row < NP ? (row & (SEQ - 1)) : (row < NP + NS ? SEQ + ((row - NP) & (SSEQ - 1)) : 0); }
__device__ __forceinline__ int key_row(int row) { return row < NP ? row : NP + ((row - NP) >> 4) * SKS + PAST + ((row - NP) & 15); }

struct EpiBf16 {
    static constexpr bool PERM = true, AFTER_DRAIN = false;
    bf16_t* O; int ldc;
    __device__ __forceinline__ void operator()(const f32x4 (&acc)[2][2][4][2], const pg8::Unit& u, int wr, int wc, int fr, int fq) const {
        const int row0 = u.pm * 256 + wr * 64 + fr, col0 = u.pn * 256 + wc * 32 + 8 * fq;
#pragma unroll
        for (int ai = 0; ai < 2; ++ai)
#pragma unroll
            for (int m = 0; m < 4; ++m) { bf16_t* rowp = O + (size_t)(row0 + ai * 128 + m * 16) * ldc + col0;
#pragma unroll
                for (int bj = 0; bj < 2; ++bj) { const f32x4 v0 = acc[ai][bj][m][0], v1 = acc[ai][bj][m][1];
                    u32x4 w; w.x = pk2(v0[0], v0[1]); w.y = pk2(v0[2], v0[3]); w.z = pk2(v1[0], v1[1]); w.w = pk2(v1[2], v1[3]);
                    *(u32x4*)(rowp + bj * 128) = w; } }
    }
};
struct EpiRelu2 {
    static constexpr bool PERM = true, AFTER_DRAIN = false;
    bf16_t* O; int ldc; const float* bias;
    __device__ __forceinline__ void operator()(const f32x4 (&acc)[2][2][4][2], const pg8::Unit& u, int wr, int wc, int fr, int fq) const {
        const int row0 = u.pm * 256 + wr * 64 + fr, col0 = u.pn * 256 + wc * 32 + 8 * fq;
        f32x4 bv[2][2];
#pragma unroll
        for (int bj = 0; bj < 2; ++bj)
#pragma unroll
            for (int n = 0; n < 2; ++n) bv[bj][n] = *(const f32x4*)(bias + col0 + bj * 128 + 4 * n);
#pragma unroll
        for (int ai = 0; ai < 2; ++ai)
#pragma unroll
            for (int m = 0; m < 4; ++m) { bf16_t* rowp = O + (size_t)(row0 + ai * 128 + m * 16) * ldc + col0;
#pragma unroll
                for (int bj = 0; bj < 2; ++bj) { f32x4 v0 = acc[ai][bj][m][0] + bv[bj][0], v1 = acc[ai][bj][m][1] + bv[bj][1];
#pragma unroll
                    for (int j = 0; j < 4; ++j) { const float a = fmaxf(v0[j], 0.f), b = fmaxf(v1[j], 0.f); v0[j] = a * a; v1[j] = b * b; }
                    u32x4 w; w.x = pk2(v0[0], v0[1]); w.y = pk2(v0[2], v0[3]); w.z = pk2(v1[0], v1[1]); w.w = pk2(v1[2], v1[3]);
                    *(u32x4*)(rowp + bj * 128) = w; } }
    }
};
struct EpiRes {
    static constexpr bool PERM = true, AFTER_DRAIN = false;
    bf16_t* T; const bf16_t* R; const float* bias;
    __device__ __forceinline__ void operator()(const f32x4 (&acc)[2][2][4][2], const pg8::Unit& u, int wr, int wc, int fr, int fq) const {
        const int row0 = u.pm * 256 + wr * 64 + fr, col0 = u.pn * 256 + wc * 32 + 8 * fq;
        f32x4 bv[2][2];
#pragma unroll
        for (int bj = 0; bj < 2; ++bj)
#pragma unroll
            for (int n = 0; n < 2; ++n) bv[bj][n] = bias ? *(const f32x4*)(bias + col0 + bj * 128 + 4 * n) : (f32x4){0.f, 0.f, 0.f, 0.f};
#pragma unroll
        for (int ai = 0; ai < 2; ++ai) {
            u32x4 xr[4][2];
#pragma unroll
            for (int m = 0; m < 4; ++m)
#pragma unroll
                for (int bj = 0; bj < 2; ++bj) xr[m][bj] = *(const u32x4*)(R + (size_t)(row0 + ai * 128 + m * 16) * 1024 + col0 + bj * 128);
#pragma unroll
            for (int m = 0; m < 4; ++m) { const size_t ro = (size_t)(row0 + ai * 128 + m * 16) * 1024 + col0;
#pragma unroll
                for (int bj = 0; bj < 2; ++bj) { const u32x4 w = xr[m][bj];
                    const f32x4 x0 = {bflo(w.x), bfhi(w.x), bflo(w.y), bfhi(w.y)}, x1 = {bflo(w.z), bfhi(w.z), bflo(w.w), bfhi(w.w)};
                    const f32x4 v0 = x0 * ALPHA + acc[ai][bj][m][0] + bv[bj][0], v1 = x1 * ALPHA + acc[ai][bj][m][1] + bv[bj][1];
                    u32x4 o; o.x = pkh(v0[0], v0[1]); o.y = pkh(v0[2], v0[3]); o.z = pkh(v1[0], v1[1]); o.w = pkh(v1[2], v1[3]);
                    *(u32x4*)(T + ro + bj * 128) = o; } }
        }
    }
};
struct EpiPart {
    static constexpr bool PERM = false, AFTER_DRAIN = false;
    float* X; int ldc; int rowsub; size_t sstride;
    __device__ __forceinline__ void operator()(const f32x4 (&acc)[2][2][4][2], const pg8::Unit& u, int wr, int wc, int fr, int fq) const {
        const int row0 = u.pm * 256 + wr * 64 + fr - rowsub, col0 = u.pn * 256 + wc * 32 + 4 * fq;
        float* base = X + (size_t)u.ks * sstride;
#pragma unroll
        for (int ai = 0; ai < 2; ++ai)
#pragma unroll
            for (int m = 0; m < 4; ++m) { float* rowp = base + (size_t)(row0 + ai * 128 + m * 16) * ldc + col0;
#pragma unroll
                for (int bj = 0; bj < 2; ++bj)
#pragma unroll
                    for (int n = 0; n < 2; ++n) *(f32x4*)(rowp + bj * 128 + n * 16) = acc[ai][bj][m][n]; }
    }
};
struct EpiQ {
    static constexpr bool PERM = true, AFTER_DRAIN = false;
    bf16_t* Q; const float* tab;
    __device__ __forceinline__ void operator()(const f32x4 (&acc)[2][2][4][2], const pg8::Unit& u, int wr, int wc, int fr, int fq) const {
        const int row0 = u.pm * 256 + wr * 64 + fr;
#pragma unroll
        for (int bj = 0; bj < 2; ++bj) {
            const int cbase = u.pn * 256 + bj * 128 + wc * 32;
            const int rel = cbase % 192;
            if (rel < 128) {
#pragma unroll
                for (int ai = 0; ai < 2; ++ai)
#pragma unroll
                    for (int m = 0; m < 4; ++m) { const f32x4 v0 = acc[ai][bj][m][0] * MLA_QS, v1 = acc[ai][bj][m][1] * MLA_QS;
                        u32x4 w; w.x = pk2(v0[0], v0[1]); w.y = pk2(v0[2], v0[3]); w.z = pk2(v1[0], v1[1]); w.w = pk2(v1[2], v1[3]);
                        *(u32x4*)(Q + (size_t)(row0 + ai * 128 + m * 16) * 768 + cbase + 8 * fq) = w; }
            } else {
                const int hb = cbase - rel + 128;
                const int i0 = 4 * (4 * (wc & 1) + fq);
#pragma unroll
                for (int ai = 0; ai < 2; ++ai) {
                    f32x4 tc[4][2];
#pragma unroll
                    for (int m = 0; m < 4; ++m) { const float* tp = tab + (size_t)pos_index(row0 + ai * 128 + m * 16) * 64 + 2 * i0; tc[m][0] = *(const f32x4*)tp; tc[m][1] = *(const f32x4*)(tp + 4); }
#pragma unroll
                    for (int m = 0; m < 4; ++m) { const int row = row0 + ai * 128 + m * 16;
                        const f32x4 cs0 = tc[m][0], cs1 = tc[m][1];
                        const f32x4 x1 = acc[ai][bj][m][0] * MLA_QS, x2 = acc[ai][bj][m][1] * MLA_QS;
                        const float a0 = x1[0] * cs0[0] - x2[0] * cs0[1], b0 = x2[0] * cs0[0] + x1[0] * cs0[1];
                        const float a1 = x1[1] * cs0[2] - x2[1] * cs0[3], b1 = x2[1] * cs0[2] + x1[1] * cs0[3];
                        const float a2 = x1[2] * cs1[0] - x2[2] * cs1[1], b2 = x2[2] * cs1[0] + x1[2] * cs1[1];
                        const float a3 = x1[3] * cs1[2] - x2[3] * cs1[3], b3 = x2[3] * cs1[2] + x1[3] * cs1[3];
                        bf16_t* qp = Q + (size_t)row * 768 + hb + i0;
                        u32x2 wa; wa.x = pk2(a0, a1); wa.y = pk2(a2, a3); *(u32x2*)qp = wa;
                        u32x2 wb; wb.x = pk2(b0, b1); wb.y = pk2(b2, b3); *(u32x2*)(qp + 32) = wb; }
                }
            }
        }
    }
};
template <class Epi>
__device__ __forceinline__ void run_gemm(const Ctx& c, const bf16_t* A, const bf16_t* Bt, int M, int N, int K, const Epi& E, int ld = 0, bool rev = false) {
    asm volatile("" : "+s"(K), "+s"(N), "+s"(M));
    pg8::Gemm g{A, Bt, M, N, K, ld ? ld : K}; pg8::StaticOrder S; S.init(M, N, (int)gridDim.x, rev ? (int)(gridDim.x - 1 - blockIdx.x) : (int)blockIdx.x);
    pg8::gemm_phase<Epi, pg8::StaticOrder>(c.lds, g, S, E);
}
template <class Epi>
__device__ __forceinline__ void run_gemm_split(const Ctx& c, const bf16_t* A, const bf16_t* Bt, int pm, int N, int K, int KS, const Epi& E, int ld = 0) {
    asm volatile("" : "+s"(K), "+s"(N), "+s"(KS));
    pg8::Gemm g{A, Bt, 256 * (pm + 1), N, KS, ld ? ld : K}; pg8::SplitOrder S{pm, N / 256, K / KS, (int)gridDim.x, (int)blockIdx.x};
    pg8::gemm_phase<Epi, pg8::SplitOrder>(c.lds, g, S, E);
}

#define XB_TMO      128
#define XB_XCNT(j)  (256  + 64 * (j))
#define XB_XSUB(j)  (1280 + 64 * (j))
#define XB_XGEN(j)  (2304 + 64 * (j))
#define XB_TOP      3328
#define XB_TOPGEN   3392
#define XCD_BAR_WORDS 3456
#define XB_SPIN_CAP (1u << 18)
__device__ __forceinline__ unsigned xb_ld(unsigned* p)              { return __hip_atomic_load(p, __ATOMIC_RELAXED, __HIP_MEMORY_SCOPE_AGENT); }
__device__ __forceinline__ unsigned xb_add(unsigned* p, unsigned v) { return __hip_atomic_fetch_add(p, v, __ATOMIC_RELAXED, __HIP_MEMORY_SCOPE_AGENT); }
__device__ __forceinline__ unsigned xb_xcc_id() { return (unsigned)__builtin_amdgcn_s_getreg((3 << 11) | 20) & 0xFu; }
#define XB_SPIN(cond, bar) do { unsigned _sp = 0; while (cond) { __builtin_amdgcn_s_sleep(1); \
    if ((++_sp & 255u) == 0u) { if (xb_ld(&(bar)[XB_TMO])) break; if (_sp > XB_SPIN_CAP) { atomicAdd(&(bar)[XB_TMO], 1u); break; } } } } while (0)
struct XcdBarrier { unsigned* bar; unsigned x; volatile LAS unsigned* st; };
__device__ __forceinline__ XcdBarrier xcd_barrier_post(unsigned* bar, volatile LAS unsigned* st) {
    XcdBarrier b; b.bar = bar; b.x = xb_xcc_id(); b.st = st;
    if (threadIdx.x == 0) (void)xb_add(&bar[XB_XCNT(b.x)], 1u);
    return b;
}
__device__ __forceinline__ void xcd_barrier_complete(unsigned* bar, unsigned x, unsigned& nloc, unsigned& nx) {
    const unsigned G = gridDim.x * gridDim.y * gridDim.z;
    unsigned sum, cnt, mine, sp = 0u;
    for (;;) {
        sum = 0u; cnt = 0u; mine = 0u;
#pragma unroll
        for (unsigned j = 0; j < 16; ++j) { const unsigned c = xb_ld(&bar[XB_XCNT(j)]); sum += c; cnt += (c > 0u) ? 1u : 0u; mine = (j == x) ? c : mine; }
        if (sum == G) break;
        __builtin_amdgcn_s_sleep(1);
        if ((++sp & 255u) == 0u) { if (xb_ld(&bar[XB_TMO])) break; if (sp > XB_SPIN_CAP) { atomicAdd(&bar[XB_TMO], 1u); break; } }
    }
    nloc = mine > 0u ? mine : 1u; nx = cnt > 0u ? cnt : 1u;
}
__device__ __forceinline__ void xcd_barrier(const XcdBarrier& b) {
    asm volatile("s_waitcnt vmcnt(0)" ::: "memory");
    __syncthreads();
    if (threadIdx.x == 0) {
        unsigned* bar = b.bar;
        unsigned bx = b.x; asm volatile("" : "+s"(bx));
        __builtin_amdgcn_s_waitcnt(0);
        unsigned nloc = b.st[0], nx = b.st[1];
        if (nloc == 0u) { xcd_barrier_complete(bar, bx, nloc, nx); b.st[0] = nloc; b.st[1] = nx; }
        const unsigned old = xb_add(&bar[XB_XSUB(bx)], 1u);
        const unsigned gen = old / nloc;
        if (old + 1u == (gen + 1u) * nloc) {
            __builtin_amdgcn_fence(__ATOMIC_RELEASE, "agent");
            asm volatile("s_waitcnt vmcnt(0)" ::: "memory");
            const unsigned og = xb_add(&bar[XB_TOP], 1u);
            const unsigned tg = og / nx;
            if (og + 1u == (tg + 1u) * nx) xb_add(&bar[XB_TOPGEN], 1u);
            else XB_SPIN(xb_ld(&bar[XB_TOPGEN]) == tg, bar);
            __builtin_amdgcn_fence(__ATOMIC_ACQUIRE, "agent");
            xb_add(&bar[XB_XGEN(bx)], 1u);
            asm volatile("s_waitcnt vmcnt(0)" ::: "memory");
        } else {
            XB_SPIN(xb_ld(&bar[XB_XGEN(bx)]) == gen, bar);
            __builtin_amdgcn_fence(__ATOMIC_ACQUIRE, "agent");
            asm volatile("s_waitcnt vmcnt(0)" ::: "memory");
        }
    }
    __syncthreads();
}
__device__ __forceinline__ void cache_convert(const Ctx& c, int l, int wg0, int part, int nparts);
__device__ __forceinline__ int uq_rowmap(int n) {
    const int h = n / 192, d = n - h * 192;
    if (d < 128) return n;
    const int e = d - 128, nn = e >> 5, i = e & 31;
    return h * 192 + 128 + 8 * (i >> 2) + 4 * nn + (i & 3);
}
struct TcTile { const float* src; bf16_t* dst; int ldS, ldD, k0, n0; bool uq; };
__device__ __forceinline__ TcTile tc_decode(const Ctx& c, int idx) {
    const float* w_in = c.in[6]; const float* w_uq = c.in[11]; const float* w_uk = c.in[12]; const float* w_uv = c.in[13];
    const float* w_out = c.in[15]; const float* w_up = c.in[18]; const float* w_down = c.in[20];
    constexpr int T_IN = 16 * 31, T_UQ = 6 * 12, T_UK = 4 * 4 * 2, T_UV = T_UK, T_OUT = 16 * 16, T_UP = 16 * 64, T_DN = 64 * 16;
    constexpr int TPL = T_IN + T_UQ + T_UK + T_UV + T_OUT + T_UP + T_DN;
    const int l = idx / TPL; int t = idx - l * TPL;
    TcTile d; d.uq = false;
    if (t < T_IN) { d.src = w_in + (size_t)l * 1024 * WIN; d.ldS = WIN; d.k0 = (t / 31) * 64; d.n0 = (t % 31) * 64; d.dst = (bf16_t*)(c.ws + WS_W1T + l * SZ_W1T); d.ldD = 1024; return d; }
    t -= T_IN;
    if (t < T_UQ) { d.src = w_uq + (size_t)l * 384 * 768; d.ldS = 768; d.k0 = (t / 12) * 64; d.n0 = (t % 12) * 64; d.dst = (bf16_t*)(c.ws + WS_WUQT + l * SZ_WUQT); d.ldD = 384; d.uq = true; return d; }
    t -= T_UQ;
    if (t < T_UK + T_UV) { const bool isv = t >= T_UK; if (isv) t -= T_UK; const int h = t / 8, r = t % 8;
        d.src = (isv ? w_uv : w_uk) + ((size_t)l * 4 + h) * 256 * 128; d.ldS = 128; d.k0 = (r / 2) * 64; d.n0 = (r % 2) * 64;
        d.dst = (bf16_t*)(c.ws + WS_WKVT + l * SZ_WKVT) + (size_t)((isv ? 512 : 0) + h * 128) * 256; d.ldD = 256; return d; }
    t -= T_UK + T_UV;
    if (t < T_OUT) { d.src = w_out + (size_t)l * 1024 * 1024; d.ldS = 1024; d.k0 = (t / 16) * 64; d.n0 = (t % 16) * 64; d.dst = (bf16_t*)(c.ws + WS_WOUTT + l * SZ_WOUTT); d.ldD = 1024; return d; }
    t -= T_OUT;
    if (t < T_UP) { d.src = w_up + (size_t)l * 1024 * 4096; d.ldS = 4096; d.k0 = (t / 64) * 64; d.n0 = (t % 64) * 64; d.dst = (bf16_t*)(c.ws + WS_WUPT + l * SZ_WUPT); d.ldD = 1024; return d; }
    t -= T_UP;
    d.src = w_down + (size_t)l * 4096 * 1024; d.ldS = 1024; d.k0 = (t / 16) * 64; d.n0 = (t % 16) * 64; d.dst = (bf16_t*)(c.ws + WS_WDNT + l * SZ_WDNT); d.ldD = HLD; return d;
}
__device__ __forceinline__ void tc_load(const Ctx& c, const TcTile& d, f32x4& a, f32x4& b) {
    const int r = c.tid >> 3, c8 = (c.tid & 7) * 8; const float* p = d.src + (size_t)(d.k0 + r) * d.ldS + d.n0 + c8;
    a = __builtin_nontemporal_load((const f32x4*)p); b = __builtin_nontemporal_load((const f32x4*)(p + 4));
}
__device__ __forceinline__ void tc_store(const Ctx& c, const TcTile& d, const f32x4& a, const f32x4& b) {
    float* sm = c.sm;
    const int r = c.tid >> 3, c8 = (c.tid & 7) * 8;
    __syncthreads();
#pragma unroll
    for (int j = 0; j < 4; ++j) { sm[r * 65 + c8 + j] = a[j]; sm[r * 65 + c8 + 4 + j] = b[j]; }
    __syncthreads();
    float v[8];
#pragma unroll
    for (int j = 0; j < 8; ++j) v[j] = sm[(c8 + j) * 65 + r];
    const int n = d.n0 + r; const int drow = d.uq ? uq_rowmap(n) : n;
    u32x4 w; w.x = pk2(v[0], v[1]); w.y = pk2(v[2], v[3]); w.z = pk2(v[4], v[5]); w.w = pk2(v[6], v[7]);
    *(u32x4*)(d.dst + (size_t)drow * d.ldD + d.k0 + c8) = w;
}
__device__ __forceinline__ void phase_prep(const Ctx& c) {
    constexpr int TPL = 16 * 31 + 6 * 12 + 2 * 4 * 4 * 2 + 16 * 16 + 16 * 64 + 64 * 16;
    {
        int idx = blockIdx.x; const int total = DEPTH * TPL, G = gridDim.x;
        f32x4 a = {0.f, 0.f, 0.f, 0.f}, b = a;
        if (idx < total) { const TcTile d = tc_decode(c, idx); tc_load(c, d, a, b); }
        while (idx < total) {
            const int nidx = idx + G; f32x4 na = a, nb = b;
            if (nidx < total) { const TcTile nd = tc_decode(c, nidx); tc_load(c, nd, na, nb); }
            { const TcTile d = tc_decode(c, idx); tc_store(c, d, a, b); }
            a = na; b = nb; idx = nidx;
        }
    }
    const size_t gt = (size_t)blockIdx.x * 512 + c.tid, gn = (size_t)gridDim.x * 512;
    for (size_t i = gt; i < (size_t)DEPTH * 64 * 1024 / 8; i += gn) { const size_t l = i / (64 * 128), r = i % (64 * 128);
        *(u32x4*)(c.ws + WS_W1T + l * SZ_W1T + (size_t)1984 * 2048 + r * 16) = (u32x4){0u, 0u, 0u, 0u}; }
    { const float* xp = c.in[0]; const float* xs = c.in[1]; float* XF = (float*)(c.ws + WS_XF); bf16_t* XB = (bf16_t*)(c.ws + WS_XB);
      for (size_t i0 = gt; i0 < (size_t)MT * 256; i0 += 4 * gn) { f32x4 v[4];
#pragma unroll
          for (int u = 0; u < 4; ++u) { const size_t e = (i0 + u * gn) * 4;
              if (e < (size_t)NP * 1024) v[u] = __builtin_nontemporal_load((const f32x4*)(xp + e)); else if (e < (size_t)(NP + NS) * 1024) v[u] = *(const f32x4*)(xs + (e - (size_t)NP * 1024)); else v[u] = (f32x4){0.f, 0.f, 0.f, 0.f}; }
#pragma unroll
          for (int u = 0; u < 4; ++u) { const size_t e = (i0 + u * gn) * 4; if (e < (size_t)MT * 1024) {
              if (e >= (size_t)NP * 1024) *(f32x4*)(XF + e) = v[u] * ALPHA; u32x2 w; w.x = pk2(v[u][0], v[u][1]); w.y = pk2(v[u][2], v[u][3]); *(u32x2*)(XB + e) = w; } } } }
    for (size_t i = gt; i < (size_t)NSB * 48 * 832 / 8; i += gn) { const size_t e = i * 8, b = e / (48 * 832), r = e % (48 * 832), row = NP + b * SKS + SNK + r / 832, col = r % 832;
        bf16_t* dst; if (col < 256) dst = (bf16_t*)(c.ws + WS_CKVK) + row * 256 + col; else if (col < 512) dst = (bf16_t*)(c.ws + WS_KC) + row * 256 + (col - 256);
        else if (col < 768) dst = (bf16_t*)(c.ws + WS_VC) + row * 256 + (col - 512); else dst = (bf16_t*)(c.ws + WS_KRK) + row * 64 + (col - 768);
        *(u32x4*)dst = (u32x4){0u, 0u, 0u, 0u}; }
    cache_convert(c, 0, 0, 0, 1);
    { float* tab = (float*)(c.ws + WS_TAB);
      for (size_t i = gt; i < (size_t)NTAB * 32; i += gn) { const int pi = (int)(i >> 5), k = (int)(i & 31); const int pos = pi < SEQ ? pi : PAST + (pi - SEQ);
          const float inv = (float)exp(-(double)k * 0.28782313662425574);
          const float ang = (float)pos * inv;
          double rev = (double)ang * 0.15915494309189535; rev -= rint(rev);
          tab[i * 2] = __builtin_amdgcn_cosf((float)rev); tab[i * 2 + 1] = __builtin_amdgcn_sinf((float)rev); } }
}

__device__ __forceinline__ void cache_convert(const Ctx& c, int l, int wg0, int part, int nparts) {
    if ((int)blockIdx.x < wg0) return;
    bf16_t* CKVK = (bf16_t*)(c.ws + WS_CKVK); bf16_t* KRK = (bf16_t*)(c.ws + WS_KRK); bf16_t* KC = (bf16_t*)(c.ws + WS_KC); bf16_t* VC = (bf16_t*)(c.ws + WS_VC);
    const size_t gt = (size_t)(blockIdx.x - wg0) * 512 + c.tid, gn = (size_t)(gridDim.x - wg0) * 512;
    { const float* cckv = c.in[2] + (size_t)l * NSB * PAST * 256; const float* ck = c.in[4] + (size_t)l * NSB * PAST * 256; const float* cv = c.in[5] + (size_t)l * NSB * PAST * 256;
      const size_t lo1 = (size_t)NSB * PAST * 64 / nparts * part, hi1 = lo1 + (size_t)NSB * PAST * 64 / nparts;
      for (size_t i0 = lo1 + gt; i0 < hi1; i0 += 4 * gn) {
          f32x4 a[4], k[4], v[4];
#pragma unroll
          for (int u = 0; u < 4; ++u) { const size_t i = i0 + u * gn; if (i < hi1) { const size_t tok = i >> 6, cc = (i & 63) * 4;
              a[u] = __builtin_nontemporal_load((const f32x4*)(cckv + tok * 256 + cc)); k[u] = __builtin_nontemporal_load((const f32x4*)(ck + tok * 256 + cc)); v[u] = __builtin_nontemporal_load((const f32x4*)(cv + tok * 256 + cc)); } }
#pragma unroll
          for (int u = 0; u < 4; ++u) { const size_t i = i0 + u * gn; if (i < hi1) { const size_t tok = i >> 6, cc = (i & 63) * 4, b = tok >> 12, j = tok & 4095, kr = NP + b * SKS + j;
              u32x2 o; o.x = pk2(a[u][0], a[u][1]); o.y = pk2(a[u][2], a[u][3]); *(u32x2*)(CKVK + kr * 256 + cc) = o;
              o.x = pk2(k[u][0], k[u][1]); o.y = pk2(k[u][2], k[u][3]); *(u32x2*)(KC + kr * 256 + cc) = o;
              o.x = pk2(v[u][0], v[u][1]); o.y = pk2(v[u][2], v[u][3]); *(u32x2*)(VC + kr * 256 + cc) = o; } } }
      const float* ckr = c.in[3] + (size_t)l * NSB * PAST * 64;
      const size_t lo2 = (size_t)NSB * PAST * 16 / nparts * part, hi2 = lo2 + (size_t)NSB * PAST * 16 / nparts;
      for (size_t i0 = lo2 + gt; i0 < hi2; i0 += 4 * gn) {
          f32x4 a[4];
#pragma unroll
          for (int u = 0; u < 4; ++u) { const size_t i = i0 + u * gn; if (i < hi2) { const size_t tok = i >> 4, cc = (i & 15) * 4; a[u] = __builtin_nontemporal_load((const f32x4*)(ckr + tok * 64 + cc)); } }
#pragma unroll
          for (int u = 0; u < 4; ++u) { const size_t i = i0 + u * gn; if (i < hi2) { const size_t tok = i >> 4, cc = (i & 15) * 4, b = tok >> 12, j = tok & 4095, kr = NP + b * SKS + j;
              u32x2 o; o.x = pk2(a[u][0], a[u][1]); o.y = pk2(a[u][2], a[u][3]); *(u32x2*)(KRK + kr * 64 + cc) = o; } } } }
}
struct P1Row { u32x2 wu, wv, wckv, wq, wk, wvv; unsigned cq0, cq1, cq2; bf16_t r1, r2; };
__device__ __forceinline__ void p1_load(P1Row& d, const bf16_t* pr, int lane) {
    d.wu = __builtin_nontemporal_load((const u32x2*)(pr + 4 * lane)); d.wv = __builtin_nontemporal_load((const u32x2*)(pr + 256 + 4 * lane));
    const unsigned* pw = (const unsigned*)(pr + 512 + 6 * lane); d.cq0 = pw[0]; d.cq1 = pw[1]; d.cq2 = pw[2];
    d.wckv = *(const u32x2*)(pr + 896 + 4 * lane); d.r1 = pr[1152 + (lane & 31)]; d.r2 = pr[1152 + 32 + (lane & 31)];
    d.wq = __builtin_nontemporal_load((const u32x2*)(pr + 1216 + 4 * lane)); d.wk = __builtin_nontemporal_load((const u32x2*)(pr + 1472 + 4 * lane)); d.wvv = __builtin_nontemporal_load((const u32x2*)(pr + 1728 + 4 * lane));
}
__device__ __forceinline__ void p1_load32(P1Row& d, const float* pr, int lane) {
    constexpr size_t SS = (size_t)256 * 2048;
    auto ld4 = [&](int off) { f32x4 v = *(const f32x4*)(pr + off);
#pragma unroll
        for (int s = 1; s < 4; ++s) v += *(const f32x4*)(pr + s * SS + off);
        u32x2 o; o.x = pk2(v[0], v[1]); o.y = pk2(v[2], v[3]); return o; };
    auto ld1 = [&](int off) { float v = pr[off];
#pragma unroll
        for (int s = 1; s < 4; ++s) v += pr[s * SS + off];
        return v; };
    d.wu = ld4(4 * lane); d.wv = ld4(256 + 4 * lane);
    { const int o = 512 + 6 * lane; d.cq0 = pk2(ld1(o), ld1(o + 1)); d.cq1 = pk2(ld1(o + 2), ld1(o + 3)); d.cq2 = pk2(ld1(o + 4), ld1(o + 5)); }
    d.wckv = ld4(896 + 4 * lane); d.r1 = f2bf(ld1(1152 + (lane & 31))); d.r2 = f2bf(ld1(1152 + 32 + (lane & 31)));
    d.wq = ld4(1216 + 4 * lane); d.wk = ld4(1472 + 4 * lane); d.wvv = ld4(1728 + 4 * lane);
}
__device__ __forceinline__ void p1_row(const Ctx& c, int l, int row, const P1Row& d, const float* g_cq, const float* g_ckv, const float* tab) {
    bf16_t* U = (bf16_t*)(c.ws + WS_U); bf16_t* V = (bf16_t*)(c.ws + WS_V); bf16_t* CQN = (bf16_t*)(c.ws + WS_CQN); bf16_t* QC = (bf16_t*)(c.ws + WS_QC);
    bf16_t* CKVK = (bf16_t*)(c.ws + WS_CKVK); bf16_t* KRK = (bf16_t*)(c.ws + WS_KRK); bf16_t* KC = (bf16_t*)(c.ws + WS_KC); bf16_t* VC = (bf16_t*)(c.ws + WS_VC);
    const int lane = c.lane;
    const bool real = row < NP + NS, samp = row >= NP;
    const int srow = row - NP;
    const int krow = key_row(real ? row : 0);
    { const u32x2 w = d.wu;
      const float a0 = gelu_tanh(bflo(w.x)), a1 = gelu_tanh(bfhi(w.x)), a2 = gelu_tanh(bflo(w.y)), a3 = gelu_tanh(bfhi(w.y));
      u32x2 o; o.x = pk2(a0, a1); o.y = pk2(a2, a3); *(u32x2*)(U + (size_t)row * 256 + 4 * lane) = o; }
    { const u32x2 w = d.wv;
      float a0 = gelu_tanh(bflo(w.x)), a1 = gelu_tanh(bfhi(w.x)), a2 = gelu_tanh(bflo(w.y)), a3 = gelu_tanh(bfhi(w.y));
      const float mu = gsum16(a0 + a1 + a2 + a3) * (1.0f / 64.0f);
      a0 -= mu; a1 -= mu; a2 -= mu; a3 -= mu;
      const float var = gsum16(a0 * a0 + a1 * a1 + a2 * a2 + a3 * a3) * (1.0f / 64.0f);
      const float rs = rsqrtf(var + EPS); a0 *= rs; a1 *= rs; a2 *= rs; a3 *= rs;
      u32x2 o; o.x = pk2(a0, a1); o.y = pk2(a2, a3); *(u32x2*)(V + (size_t)row * 256 + 4 * lane) = o;
      if (real && samp) *(f32x4*)(c.out + O_GV + ((size_t)l * NS + srow) * 256 + 4 * lane) = (f32x4){a0, a1, a2, a3}; }
    { float a[6] = {bflo(d.cq0), bfhi(d.cq0), bflo(d.cq1), bfhi(d.cq1), bflo(d.cq2), bfhi(d.cq2)};
      float ss = 0.f;
#pragma unroll
      for (int j = 0; j < 6; ++j) ss += a[j] * a[j];
      const float rs = rsqrtf(wsum(ss) * (1.0f / 384.0f) + EPS);
#pragma unroll
      for (int j = 0; j < 6; ++j) a[j] *= rs * g_cq[6 * lane + j];
      unsigned* po = (unsigned*)(CQN + (size_t)row * 384 + 6 * lane); po[0] = pk2(a[0], a[1]); po[1] = pk2(a[2], a[3]); po[2] = pk2(a[4], a[5]); }
    { const u32x2 w = d.wckv;
      float a0 = bflo(w.x), a1 = bfhi(w.x), a2 = bflo(w.y), a3 = bfhi(w.y);
      const float rs = rsqrtf(wsum(a0 * a0 + a1 * a1 + a2 * a2 + a3 * a3) * (1.0f / 256.0f) + EPS);
      const f32x4 g = *(const f32x4*)(g_ckv + 4 * lane);
      a0 *= rs * g[0]; a1 *= rs * g[1]; a2 *= rs * g[2]; a3 *= rs * g[3];
      if (real) {
          float* op = samp ? c.out + O_CKVS + ((size_t)l * NS + srow) * 256 : c.out + O_CKVP + ((size_t)l * NP + row) * 256;
          __builtin_nontemporal_store((f32x4){a0, a1, a2, a3}, (f32x4*)(op + 4 * lane));
          u32x2 o; o.x = pk2(a0, a1); o.y = pk2(a2, a3); *(u32x2*)(CKVK + (size_t)krow * 256 + 4 * lane) = o; } }
    { const int i = lane & 31; const float x1 = bf2f(d.r1), x2 = bf2f(d.r2);
      const f32x2v t = *(const f32x2v*)(tab + (size_t)pos_index(row) * 64 + 2 * i);
      const float o1 = x1 * t.x - x2 * t.y, o2 = x2 * t.x + x1 * t.y;
      if (real && lane < 32) {
          float* op = samp ? c.out + O_KRS + ((size_t)l * NS + srow) * 64 : c.out + O_KRP + ((size_t)l * NP + row) * 64;
          __builtin_nontemporal_store(o1, op + i); __builtin_nontemporal_store(o2, op + 32 + i);
          KRK[(size_t)krow * 64 + i] = f2bf(o1); KRK[(size_t)krow * 64 + 32 + i] = f2bf(o2); } }
    { const u32x2 w = d.wq;
      u32x2 o; o.x = pk2(bflo(w.x) * 0.125f, bfhi(w.x) * 0.125f); o.y = pk2(bflo(w.y) * 0.125f, bfhi(w.y) * 0.125f);
      *(u32x2*)(QC + (size_t)row * 256 + 4 * lane) = o; }
    if (real) {
        const u32x2 wk = d.wk, wv = d.wvv;
        float* ok = samp ? c.out + O_KS + ((size_t)l * NS + srow) * 256 : c.out + O_KP + ((size_t)l * NP + row) * 256;
        float* ov = samp ? c.out + O_VS + ((size_t)l * NS + srow) * 256 : c.out + O_VP + ((size_t)l * NP + row) * 256;
        __builtin_nontemporal_store((f32x4){bflo(wk.x), bfhi(wk.x), bflo(wk.y), bfhi(wk.y)}, (f32x4*)(ok + 4 * lane));
        __builtin_nontemporal_store((f32x4){bflo(wv.x), bfhi(wv.x), bflo(wv.y), bfhi(wv.y)}, (f32x4*)(ov + 4 * lane));
        *(u32x2*)(KC + (size_t)krow * 256 + 4 * lane) = wk; *(u32x2*)(VC + (size_t)krow * 256 + 4 * lane) = wv;
    }
}
__device__ __forceinline__ void phase_post1(const Ctx& c, int l) {
    const bf16_t* P = (const bf16_t*)(c.ws + WS_P); const float* PS32 = (const float*)(c.ws + WS_PS32);
    bf16_t* CKVK = (bf16_t*)(c.ws + WS_CKVK); bf16_t* KRK = (bf16_t*)(c.ws + WS_KRK); bf16_t* KC = (bf16_t*)(c.ws + WS_KC); bf16_t* VC = (bf16_t*)(c.ws + WS_VC);
    const float* tab = (const float*)(c.ws + WS_TAB);
    const float* g_cq = c.in[9] + l * 384; const float* g_ckv = c.in[10] + l * 256;
    const int W = gridDim.x * 8;
    for (int row = blockIdx.x * 8 + c.wave; row < NP; row += 2 * W) {
        const int row2 = row + W; const bool has2 = row2 < NP;
        P1Row d0, d1;
        p1_load(d0, P + (size_t)row * 2048, c.lane);
        p1_load(d1, P + (size_t)(has2 ? row2 : row) * 2048, c.lane);
        p1_row(c, l, row, d0, g_cq, g_ckv, tab);
        if (has2) p1_row(c, l, row2, d1, g_cq, g_ckv, tab);
    }
    for (int row = NP + blockIdx.x * 8 + c.wave; row < MT; row += W) {
        P1Row d0;
        p1_load32(d0, PS32 + (size_t)(row - NP) * 2048, c.lane);
        p1_row(c, l, row, d0, g_cq, g_ckv, tab);
    }
}
#define EX2(x) __builtin_amdgcn_exp2f(x)
typedef unsigned u32x2s __attribute__((ext_vector_type(2)));
__device__ __forceinline__ float xor32(float v, int lane) {
    const unsigned x = __builtin_bit_cast(unsigned, v);
    const u32x2s r = __builtin_amdgcn_permlane32_swap(x, x, false, false);
    return __builtin_bit_cast(float, (lane & 32) ? r[0] : r[1]);
}
#define MFMA32(a, b, c) __builtin_amdgcn_mfma_f32_32x32x16_bf16((a), (b), (c), 0, 0, 0)
__device__ __forceinline__ int crow(int reg, int h) { return (reg & 3) + 8 * (reg >> 2) + 4 * h; }
__device__ __forceinline__ bf16x8 pack8(const f32x16& x, int s) {
    u32x4 p; p.x = pk2(x[8 * s], x[8 * s + 1]); p.y = pk2(x[8 * s + 2], x[8 * s + 3]); p.z = pk2(x[8 * s + 4], x[8 * s + 5]); p.w = pk2(x[8 * s + 6], x[8 * s + 7]);
    return __builtin_bit_cast(bf16x8, p);
}
constexpr int MLA_KS = 400, MLA_VS = 320, MLA_VOFF = 64 * MLA_KS, MLA_BUF = 64 * (MLA_KS + MLA_VS);
__device__ __forceinline__ void mla_item(const Ctx& c, int qrow0, int nqv, int head, int keybase, int nk, int t_lo, int t_hi, int qpos0, float* part) {
    const bf16_t* Q = (const bf16_t*)(c.ws + WS_Q); const bf16_t* KVE = (const bf16_t*)(c.ws + WS_P); const bf16_t* KRK = (const bf16_t*)(c.ws + WS_KRK);
    bf16_t* YRAW = (bf16_t*)(c.ws + WS_YRAW);
    int tid_ = c.tid; asm volatile("" : "+v"(tid_));
    const int tid = tid_, lane = tid & 63, w = c.wave, r = lane & 31, h2 = lane >> 5;
    const int qi = w * 32 + r;
    const bool wactive = (w * 32 < nqv);
    const int tmax = (qpos0 + w * 32) >> 6;
    bf16x8 qf[12];
    { const bf16_t* qp = Q + (size_t)(qrow0 + (qi < nqv ? qi : nqv - 1)) * 768 + head * 192 + 8 * h2;
#pragma unroll
      for (int s = 0; s < 12; ++s) qf[s] = *(const bf16x8*)(qp + 16 * s); }
    f32x16 O[4];
#pragma unroll
    for (int cb = 0; cb < 4; ++cb)
#pragma unroll
        for (int i = 0; i < 16; ++i) O[cb][i] = 0.f;
    float mrun = -1e30f, lsum = 0.f;
    u32x4 stg[5];
    const bf16_t* pN = KVE + (size_t)(keybase + (tid >> 4)) * 1024 + head * 128 + 8 * (tid & 15);
    const bf16_t* pR = KRK + (size_t)(keybase + (tid >> 3)) * 64 + 8 * (tid & 7);
    LAS unsigned char* dN = c.lds + (tid >> 4) * MLA_KS + 16 * (tid & 15);
    LAS unsigned char* dR = c.lds + (tid >> 3) * MLA_KS + 256 + 16 * (tid & 7);
    LAS unsigned char* dV = c.lds + MLA_VOFF + (tid >> 4) * MLA_VS + 16 * (tid & 15);
#define MLA_PREFETCH(t) do { const bf16_t* a_ = pN + (size_t)(t) * 65536; stg[0] = *(const u32x4*)a_; stg[1] = *(const u32x4*)(a_ + 32768); stg[2] = *(const u32x4*)(a_ + 512); stg[3] = *(const u32x4*)(a_ + 32768 + 512); \
        stg[4] = *(const u32x4*)(pR + (size_t)(t) * 4096); } while (0)
#define MLA_COMMIT(o) do { *(LAS u32x4*)(dN + (o)) = stg[0]; *(LAS u32x4*)(dN + (o) + 32 * MLA_KS) = stg[1]; *(LAS u32x4*)(dV + (o)) = stg[2]; *(LAS u32x4*)(dV + (o) + 32 * MLA_VS) = stg[3]; *(LAS u32x4*)(dR + (o)) = stg[4]; } while (0)
    MLA_PREFETCH(t_lo);
    if (w >= 4) __builtin_amdgcn_s_setprio(2);
    const int q4 = (lane & 15) >> 2, p4 = lane & 3, blk = (lane >> 4) & 1;
    __syncthreads();
    MLA_COMMIT(0);
    __syncthreads();
    if (t_lo + 1 < t_hi) MLA_PREFETCH(t_lo + 1);
    for (int t = t_lo; t < t_hi; ++t) {
        const int bo = ((t - t_lo) & 1) * MLA_BUF;
        if (wactive && t <= tmax) {
            f32x16 sa[2];
#pragma unroll
            for (int kb = 0; kb < 2; ++kb)
#pragma unroll
                for (int i = 0; i < 16; ++i) sa[kb][i] = 0.f;
            { LAS unsigned char* kp = c.lds + bo + r * MLA_KS + 16 * h2;
#pragma unroll
              for (int s = 0; s < 12; ++s) {
                  const bf16x8 k0 = *(LAS bf16x8*)(kp + 32 * s), k1 = *(LAS bf16x8*)(kp + 32 * MLA_KS + 32 * s);
                  sa[0] = MFMA32(k0, qf[s], sa[0]); sa[1] = MFMA32(k1, qf[s], sa[1]);
                  if ((s & 3) == 3) __builtin_amdgcn_sched_barrier(0);
              } }
            if (64 * t + 63 >= nk) {
                asm volatile("" ::: "memory");
#pragma unroll
                for (int kb = 0; kb < 2; ++kb)
#pragma unroll
                    for (int i = 0; i < 16; ++i) if (64 * t + 32 * kb + crow(i, h2) >= nk) sa[kb][i] = -1e30f;
            }
            float mx = sa[0][0];
#pragma unroll
            for (int kb = 0; kb < 2; ++kb)
#pragma unroll
                for (int i = 0; i < 16; ++i) mx = fmaxf(mx, sa[kb][i]);
            mx = fmaxf(mx, xor32(mx, lane));
            const float mnew = fmaxf(mrun, mx), alpha = EX2(mrun - mnew);
            mrun = mnew;
            float ps = 0.f;
#pragma unroll
            for (int kb = 0; kb < 2; ++kb)
#pragma unroll
                for (int i = 0; i < 16; ++i) { const float p = EX2(sa[kb][i] - mnew); sa[kb][i] = p; ps += p; }
            lsum = lsum * alpha + ps;
            if (__ballot(alpha != 1.0f) != 0ull) {
#pragma unroll
                for (int cb = 0; cb < 4; ++cb)
#pragma unroll
                    for (int i = 0; i < 16; ++i) O[cb][i] *= alpha;
            }
#pragma unroll
            for (int kb = 0; kb < 2; ++kb)
#pragma unroll
                for (int s2 = 0; s2 < 2; ++s2) {
                    const bf16x8 pb = pack8(sa[kb], s2);
                    LAS unsigned char* vp = c.lds + bo + MLA_VOFF + (32 * kb + 16 * s2 + 4 * h2 + q4) * MLA_VS + 32 * blk + 8 * p4;
#pragma unroll
                    for (int cb = 0; cb < 4; ++cb) {
                        const s16x4 lo = __builtin_amdgcn_ds_read_tr16_b64_v4i16((LAS s16x4*)(vp + 64 * cb));
                        const s16x4 hi = __builtin_amdgcn_ds_read_tr16_b64_v4i16((LAS s16x4*)(vp + 64 * cb + 8 * MLA_VS));
                        const bf16x8 va = __builtin_shufflevector(lo, hi, 0, 1, 2, 3, 4, 5, 6, 7);
                        O[cb] = MFMA32(va, pb, O[cb]);
                    }
                    __builtin_amdgcn_sched_barrier(0);
                }
        }
        if (t + 1 < t_hi) MLA_COMMIT(MLA_BUF - bo);
        __syncthreads();
        if (t + 2 < t_hi) MLA_PREFETCH(t + 2);
    }
#undef MLA_PREFETCH
#undef MLA_COMMIT
    __builtin_amdgcn_s_setprio(0);
    if (!wactive) return;
    const float ltot = lsum + xor32(lsum, lane);
    if (part == nullptr) {
        const float inv = 1.0f / ltot;
        bf16_t* yp = YRAW + (size_t)(qrow0 + qi) * 1024 + 256 + head * 128 + 4 * h2;
#pragma unroll
        for (int cb = 0; cb < 4; ++cb)
#pragma unroll
            for (int g = 0; g < 4; ++g) { u32x2 o; o.x = pk2(O[cb][4 * g] * inv, O[cb][4 * g + 1] * inv); o.y = pk2(O[cb][4 * g + 2] * inv, O[cb][4 * g + 3] * inv);
                *(u32x2*)(yp + 32 * cb + 8 * g) = o; }
    } else if (qi < nqv) {
#pragma unroll
        for (int cb = 0; cb < 4; ++cb)
#pragma unroll
            for (int g = 0; g < 4; ++g) *(f32x4*)(part + qi * 128 + 32 * cb + 8 * g + 4 * h2) = (f32x4){O[cb][4 * g], O[cb][4 * g + 1], O[cb][4 * g + 2], O[cb][4 * g + 3]};
        if (h2 == 0) { part[2048 + qi] = mrun; part[2064 + qi] = ltot; }
    }
}

constexpr int SB_KS = 144, SB_VS = 192, SB_VOFF = 64 * SB_KS;
__device__ __forceinline__ void sb_item(const Ctx& c, int qrow0, int nqv, int head, int keybase, int t_lo, int t_hi, int qpos0, float* part) {
    const bf16_t* QC = (const bf16_t*)(c.ws + WS_QC); const bf16_t* KC = (const bf16_t*)(c.ws + WS_KC); const bf16_t* VC = (const bf16_t*)(c.ws + WS_VC);
    bf16_t* YRAW = (bf16_t*)(c.ws + WS_YRAW);
    int tid_ = c.tid; asm volatile("" : "+v"(tid_));
    const int tid = tid_, lane = tid & 63, w = c.wave, r = lane & 31, h2 = lane >> 5;
    const int qi = w * 32 + r;
    const bool wactive = (w * 32 < nqv);
    const int qpos = qpos0 + qi;
    const int tdiag = (qpos0 + w * 32) >> 6;
    bf16x8 qf[4];
    { const bf16_t* qp = QC + (size_t)(qrow0 + (qi < nqv ? qi : nqv - 1)) * 256 + head * 64 + 8 * h2;
#pragma unroll
      for (int s = 0; s < 4; ++s) qf[s] = *(const bf16x8*)(qp + 16 * s); }
    f32x16 O[2];
#pragma unroll
    for (int cb = 0; cb < 2; ++cb)
#pragma unroll
        for (int i = 0; i < 16; ++i) O[cb][i] = 0.f;
    float R = 1.0f;
    u32x4 stg[2];
    const size_t sboff = (size_t)(keybase + (tid >> 3)) * 256 + head * 64 + 8 * (tid & 7);
    const bf16_t* pK = KC + sboff; const bf16_t* pV = VC + sboff;
    LAS unsigned char* dK = c.lds + (tid >> 3) * SB_KS + 16 * (tid & 7);
    LAS unsigned char* dV = c.lds + SB_VOFF + (tid >> 3) * SB_VS + 16 * (tid & 7);
#define SB_PREFETCH(t) do { stg[0] = *(const u32x4*)(pK + (size_t)(t) * 16384); stg[1] = *(const u32x4*)(pV + (size_t)(t) * 16384); } while (0)
#define SB_COMMIT() do { *(LAS u32x4*)dK = stg[0]; *(LAS u32x4*)dV = stg[1]; } while (0)
    SB_PREFETCH(t_hi - 1);
    if (w >= 4) __builtin_amdgcn_s_setprio(2);
    const int q4 = (lane & 15) >> 2, p4 = lane & 3, blk = (lane >> 4) & 1;
    int alive = 1;
    for (int t = t_hi - 1; t >= t_lo; --t) {
        if (!__syncthreads_or(alive)) break;
        SB_COMMIT();
        __syncthreads();
        if (t - 1 >= t_lo) SB_PREFETCH(t - 1);
        if (wactive && t <= tdiag) {
            const bool diag = (t == tdiag);
#pragma unroll
            for (int kb = 1; kb >= 0; --kb) {
                f32x16 z;
#pragma unroll
                for (int i = 0; i < 16; ++i) z[i] = 0.f;
                LAS unsigned char* kp = c.lds + (32 * kb + r) * SB_KS + 16 * h2;
#pragma unroll
                for (int s = 0; s < 4; ++s) z = MFMA32(*(LAS bf16x8*)(kp + 32 * s), qf[s], z);
                float rr[16];
#pragma unroll
                for (int i = 0; i < 16; ++i) { const float e = EX2(fminf(z[i] * LOG2E, 64.0f)); z[i] = e; rr[i] = __builtin_amdgcn_rcpf(1.0f + e); }
                if (diag) {
                    asm volatile("" ::: "memory");
#pragma unroll
                    for (int i = 0; i < 16; ++i) if (64 * t + 32 * kb + crow(i, h2) >= qpos) { z[i] = 0.f; rr[i] = 1.0f; }
                }
                float seg[4], pt[4];
#pragma unroll
                for (int g = 0; g < 4; ++g) { rr[4 * g + 2] *= rr[4 * g + 3]; rr[4 * g + 1] *= rr[4 * g + 2]; rr[4 * g] *= rr[4 * g + 1]; seg[g] = rr[4 * g]; }
#pragma unroll
                for (int g = 0; g < 4; ++g) pt[g] = xor32(seg[g], lane);
                float off[4]; float acc = R;
#pragma unroll
                for (int g = 3; g >= 0; --g) { off[g] = h2 ? acc : acc * pt[g]; acc *= seg[g] * pt[g]; }
#pragma unroll
                for (int i = 0; i < 16; ++i) z[i] = z[i] * rr[i] * off[i >> 2];
                R = acc;
#pragma unroll
                for (int s2 = 0; s2 < 2; ++s2) {
                    const bf16x8 pb = pack8(z, s2);
                    LAS unsigned char* vp = c.lds + SB_VOFF + (32 * kb + 16 * s2 + 4 * h2 + q4) * SB_VS + 32 * blk + 8 * p4;
#pragma unroll
                    for (int cb = 0; cb < 2; ++cb) {
                        const s16x4 lo = __builtin_amdgcn_ds_read_tr16_b64_v4i16((LAS s16x4*)(vp + 64 * cb));
                        const s16x4 hi = __builtin_amdgcn_ds_read_tr16_b64_v4i16((LAS s16x4*)(vp + 64 * cb + 8 * SB_VS));
                        const bf16x8 va = __builtin_shufflevector(lo, hi, 0, 1, 2, 3, 4, 5, 6, 7);
                        O[cb] = MFMA32(va, pb, O[cb]);
                    }
                }
            }
        }
        alive = wactive && ((t - 1 > tdiag) || (__ballot(R != 0.f) != 0ull));
    }
#undef SB_PREFETCH
#undef SB_COMMIT
    __builtin_amdgcn_s_setprio(0);
    if (!wactive) return;
    if (part == nullptr) {
        bf16_t* yp = YRAW + (size_t)(qrow0 + qi) * 1024 + 768 + head * 64 + 4 * h2;
#pragma unroll
        for (int cb = 0; cb < 2; ++cb)
#pragma unroll
            for (int g = 0; g < 4; ++g) { u32x2 o; o.x = pk2(O[cb][4 * g], O[cb][4 * g + 1]); o.y = pk2(O[cb][4 * g + 2], O[cb][4 * g + 3]); *(u32x2*)(yp + 32 * cb + 8 * g) = o; }
    } else if (qi < nqv) {
#pragma unroll
        for (int cb = 0; cb < 2; ++cb)
#pragma unroll
            for (int g = 0; g < 4; ++g) *(f32x4*)(part + qi * 64 + 32 * cb + 8 * g + 4 * h2) = (f32x4){O[cb][4 * g], O[cb][4 * g + 1], O[cb][4 * g + 2], O[cb][4 * g + 3]};
        if (h2 == 0) part[1024 + qi] = R;
    }
}
constexpr int GM_VS = 576;
__device__ __forceinline__ void gmlp_item(const Ctx& c, int l, int row0, int n) {
    const bf16_t* U = (const bf16_t*)(c.ws + WS_U); const bf16_t* V = (const bf16_t*)(c.ws + WS_V); bf16_t* YRAW = (bf16_t*)(c.ws + WS_YRAW);
    const float* w_s = c.in[7] + (size_t)l * 4 * 128 * 128; const float* b_s = c.in[8] + (size_t)l * 4 * 128;
    int tid_ = c.tid; asm volatile("" : "+v"(tid_));
    const int tid = tid_, lane = tid & 63, w = c.wave, r = lane & 31, h2 = lane >> 5;
    __syncthreads();
#pragma unroll
    for (int k = 0; k < 8; ++k) { const int i = tid + 512 * k, row = i >> 5, ch = i & 31;
        const u32x4 v = row < n ? *(const u32x4*)(V + (size_t)(row0 + row) * 256 + 8 * ch) : (u32x4){0u, 0u, 0u, 0u};
        *(LAS u32x4*)(c.lds + row * GM_VS + 16 * ch) = v; }
    __syncthreads();
    const int g = w >> 1, ih = w & 1;
    if (n < 128 && ih == 1) return;
    const int q4 = (lane & 15) >> 2, p4 = lane & 3, blk = (lane >> 4) & 1;
#pragma unroll 1
    for (int ibl = 0; ibl < 2; ++ibl) {
        const int ib = 2 * ih + ibl;
        if (32 * ib >= n) break;
        const int i = 32 * ib + r; const bool ivalid = i < n; const int ic = ivalid ? i : n - 1;
        const int kmax = (n == 128) ? (ib < 2 ? 4 : 8) : 1;
        f32x16 acc[2];
#pragma unroll
        for (int db = 0; db < 2; ++db)
#pragma unroll
            for (int e = 0; e < 16; ++e) acc[db][e] = 0.f;
        const float* wp = w_s + ((size_t)g * 128 + ic) * 128 + 8 * h2;
        LAS unsigned char* vp = c.lds + (8 * h2 + q4) * GM_VS + (g * 64 + 16 * blk) * 2 + 8 * p4;
        for (int s = 0; s < kmax; ++s) {
            const f32x4 wa = *(const f32x4*)(wp + 16 * s), wb = *(const f32x4*)(wp + 16 * s + 4);
            u32x4 pw; pw.x = pk2(wa[0], wa[1]); pw.y = pk2(wa[2], wa[3]); pw.z = pk2(wb[0], wb[1]); pw.w = pk2(wb[2], wb[3]);
            const bf16x8 bfrag = __builtin_bit_cast(bf16x8, pw);
#pragma unroll
            for (int db = 0; db < 2; ++db) {
                const s16x4 lo = __builtin_amdgcn_ds_read_tr16_b64_v4i16((LAS s16x4*)(vp + 16 * s * GM_VS + 64 * db));
                const s16x4 hi = __builtin_amdgcn_ds_read_tr16_b64_v4i16((LAS s16x4*)(vp + (16 * s + 4) * GM_VS + 64 * db));
                const bf16x8 va = __builtin_shufflevector(lo, hi, 0, 1, 2, 3, 4, 5, 6, 7);
                acc[db] = MFMA32(va, bfrag, acc[db]);
            }
        }
        if (ivalid) {
            const float bb = b_s[g * 128 + i];
#pragma unroll
            for (int db = 0; db < 2; ++db)
#pragma unroll
                for (int gq = 0; gq < 4; ++gq) { const int d0 = g * 64 + 32 * db + 8 * gq + 4 * h2;
                    const u32x2 uu = *(const u32x2*)(U + (size_t)(row0 + i) * 256 + d0);
                    u32x2 o; o.x = pk2(bflo(uu.x) * (acc[db][4 * gq] + bb), bfhi(uu.x) * (acc[db][4 * gq + 1] + bb)); o.y = pk2(bflo(uu.y) * (acc[db][4 * gq + 2] + bb), bfhi(uu.y) * (acc[db][4 * gq + 3] + bb));
                    *(u32x2*)(YRAW + (size_t)(row0 + i) * 1024 + d0) = o; }
        }
    }
}

__device__ __forceinline__ void phase_attn(const Ctx& c, int l) {
    const int G = gridDim.x;
    float* PM = (float*)(c.ws + WS_PM); float* PS = (float*)(c.ws + WS_PS);
    for (int blk = blockIdx.x; blk < 256; blk += G) {
        const int it = (G == 256) ? ((blk & 7) * 32 + (blk >> 3)) : blk;
        const int b = it >> 4, h = (it >> 2) & 3, qq = it & 3;
        const int sb = it >> 5, sh = (it >> 3) & 3, sj = it & 7; const int t0 = (65 * sj) / NSPLIT, t1 = (65 * (sj + 1)) / NSPLIT;
#ifndef NO_MLA
#pragma unroll 1
        for (int k = 0; k < 3; ++k) {
            const int qb = k == 0 ? 7 - qq : qq;
            const bool pr = k < 2;
            mla_item(c, pr ? b * SEQ + qb * 256 : NP + sb * SSEQ, pr ? 256 : SSEQ, pr ? h : sh, pr ? b * SEQ : NP + sb * SKS, pr ? SEQ : SNK, pr ? 0 : t0, pr ? 4 * (qb + 1) : t1, pr ? qb * 256 : PAST,
                     pr ? nullptr : PM + (size_t)it * PM_STRIDE);
        }
#endif
#ifndef NO_SB
#pragma unroll 1
        for (int k = 0; k < 3; ++k) {
            const int qb = k == 0 ? 7 - qq : qq;
            const bool pr = k < 2;
            sb_item(c, pr ? b * SEQ + qb * 256 : NP + sb * SSEQ, pr ? 256 : SSEQ, pr ? h : sh, pr ? b * SEQ : NP + sb * SKS, pr ? 0 : t0, pr ? 4 * (qb + 1) : t1, pr ? qb * 256 : PAST,
                    pr ? nullptr : PS + (size_t)it * PS_STRIDE);
        }
#endif
#ifndef NO_GMLP
#pragma unroll 1
        for (int k = 0; k < 2; ++k) {
            if (k == 1 && it >= NSB) break;
            gmlp_item(c, l, k == 0 ? it * 128 : NP + it * SSEQ, k == 0 ? 128 : SSEQ);
        }
#endif
    }
}

__device__ __forceinline__ void p2_unpack(const u32x2 xa, const u32x4 xb, const u32x2 xc, float (&ya)[4], float (&yb)[8], float (&yc)[4]) {
    ya[0] = bflo(xa.x); ya[1] = bfhi(xa.x); ya[2] = bflo(xa.y); ya[3] = bfhi(xa.y);
    yb[0] = bflo(xb.x); yb[1] = bfhi(xb.x); yb[2] = bflo(xb.y); yb[3] = bfhi(xb.y); yb[4] = bflo(xb.z); yb[5] = bfhi(xb.z); yb[6] = bflo(xb.w); yb[7] = bfhi(xb.w);
    yc[0] = bflo(xc.x); yc[1] = bfhi(xc.x); yc[2] = bflo(xc.y); yc[3] = bfhi(xc.y);
}
__device__ __forceinline__ void p2_finish(const Ctx& c, int row, const float (&ya)[4], const float (&yb)[8], const float (&yc)[4], const float* gm, bf16_t* Y) {
    const int lane = c.lane;
    float sa = 0.f, sb = 0.f, sc2 = 0.f;
#pragma unroll
    for (int k = 0; k < 4; ++k) { sa += ya[k] * ya[k]; sc2 += yc[k] * yc[k]; }
#pragma unroll
    for (int k = 0; k < 8; ++k) sb += yb[k] * yb[k];
    const float ra = rsqrtf(wsum(sa) * (1.0f / 256.0f) + EPS), rb = rsqrtf(wsum(sb) * (1.0f / 512.0f) + EPS), rc = rsqrtf(wsum(sc2) * (1.0f / 256.0f) + EPS);
    bf16_t* yo = Y + (size_t)row * 1024;
    { const f32x4 g = *(const f32x4*)(gm + 4 * lane); u32x2 o; o.x = pk2(ya[0] * ra * g[0], ya[1] * ra * g[1]); o.y = pk2(ya[2] * ra * g[2], ya[3] * ra * g[3]); *(u32x2*)(yo + 4 * lane) = o; }
    { const f32x4 g0 = *(const f32x4*)(gm + 256 + 8 * lane), g1 = *(const f32x4*)(gm + 256 + 8 * lane + 4); u32x4 o;
      o.x = pk2(yb[0] * rb * g0[0], yb[1] * rb * g0[1]); o.y = pk2(yb[2] * rb * g0[2], yb[3] * rb * g0[3]); o.z = pk2(yb[4] * rb * g1[0], yb[5] * rb * g1[1]); o.w = pk2(yb[6] * rb * g1[2], yb[7] * rb * g1[3]);
      *(u32x4*)(yo + 256 + 8 * lane) = o; }
    { const f32x4 g = *(const f32x4*)(gm + 768 + 4 * lane); u32x2 o; o.x = pk2(yc[0] * rc * g[0], yc[1] * rc * g[1]); o.y = pk2(yc[2] * rc * g[2], yc[3] * rc * g[3]); *(u32x2*)(yo + 768 + 4 * lane) = o; }
}
__device__ __forceinline__ void phase_post2(const Ctx& c, int l) {
    const bf16_t* YRAW = (const bf16_t*)(c.ws + WS_YRAW); bf16_t* Y = (bf16_t*)(c.ws + WS_Y);
    const float* PM = (const float*)(c.ws + WS_PM); const float* PS = (const float*)(c.ws + WS_PS);
    const float* gm = c.in[14] + (size_t)l * 1024;
    const int lane = c.lane;
    const int W = gridDim.x * 8;
    for (int row = blockIdx.x * 8 + c.wave; row < NP; row += 2 * W) {
        const int row2 = row + W; const bool has2 = row2 < NP; const int rb = has2 ? row2 : row;
        const bf16_t* y0 = YRAW + (size_t)row * 1024; const bf16_t* y1 = YRAW + (size_t)rb * 1024;
        const u32x2 a0 = *(const u32x2*)(y0 + 4 * lane), a1 = *(const u32x2*)(y1 + 4 * lane);
        const u32x4 b0 = *(const u32x4*)(y0 + 256 + 8 * lane), b1 = *(const u32x4*)(y1 + 256 + 8 * lane);
        const u32x2 c0 = *(const u32x2*)(y0 + 768 + 4 * lane), c1 = *(const u32x2*)(y1 + 768 + 4 * lane);
        float ya[4], yb[8], yc[4];
        p2_unpack(a0, b0, c0, ya, yb, yc); p2_finish(c, row, ya, yb, yc, gm, Y);
        if (has2) { p2_unpack(a1, b1, c1, ya, yb, yc); p2_finish(c, row2, ya, yb, yc, gm, Y); }
    }
    for (int row = NP + blockIdx.x * 8 + c.wave; row < MT; row += W) {
        const bf16_t* yr = YRAW + (size_t)row * 1024;
        float ya[4], yb[8], yc[4];
        p2_unpack(*(const u32x2*)(yr + 4 * lane), *(const u32x4*)(yr + 256 + 8 * lane), *(const u32x2*)(yr + 768 + 4 * lane), ya, yb, yc);
        if (row < NP + NS) {
            const int srow = row - NP, b = srow >> 4, s = srow & 15;
            { const int head = lane >> 4, cc = (8 * lane) & 127; const float* base = PM + (size_t)((b * 4 + head) * NSPLIT) * PM_STRIDE;
              float mm = -1e30f;
#pragma unroll
              for (int j = 0; j < NSPLIT; ++j) mm = fmaxf(mm, base[j * PM_STRIDE + 2048 + s]);
              float den = 0.f;
#pragma unroll
              for (int k = 0; k < 8; ++k) yb[k] = 0.f;
#pragma unroll
              for (int j = 0; j < NSPLIT; ++j) { const float sc = exp2f(base[j * PM_STRIDE + 2048 + s] - mm); den += sc * base[j * PM_STRIDE + 2064 + s];
                  const f32x4 o0 = *(const f32x4*)(base + j * PM_STRIDE + s * 128 + cc), o1 = *(const f32x4*)(base + j * PM_STRIDE + s * 128 + cc + 4);
#pragma unroll
                  for (int k = 0; k < 4; ++k) { yb[k] += sc * o0[k]; yb[4 + k] += sc * o1[k]; } }
              const float inv = 1.0f / den;
#pragma unroll
              for (int k = 0; k < 8; ++k) yb[k] *= inv; }
            { const int head = lane >> 4, cc = (4 * lane) & 63; const float* base = PS + (size_t)((b * 4 + head) * NSPLIT) * PS_STRIDE;
              float sc = 1.0f;
#pragma unroll
              for (int k = 0; k < 4; ++k) yc[k] = 0.f;
#pragma unroll
              for (int j = NSPLIT - 1; j >= 0; --j) { const f32x4 o = *(const f32x4*)(base + j * PS_STRIDE + s * 64 + cc);
#pragma unroll
                  for (int k = 0; k < 4; ++k) yc[k] += sc * o[k];
                  sc *= base[j * PS_STRIDE + 1024 + s]; } }
        }
        p2_finish(c, row, ya, yb, yc, gm, Y);
    }
}

__device__ __forceinline__ void phase_ln(const Ctx& c, const float* g, const float* b, const float* preb, bool final, int nsplit) {
    float* XF = (float*)(c.ws + WS_XF); bf16_t* XB = (bf16_t*)(c.ws + WS_XB); const bf16_t* TB = (const bf16_t*)(c.ws + WS_XF);
    const int lane = c.lane;
    f32x4 gg[4], bb[4];
#pragma unroll
    for (int k = 0; k < 4; ++k) { gg[k] = *(const f32x4*)(g + 256 * k + 4 * lane); bb[k] = *(const f32x4*)(b + 256 * k + 4 * lane); }
    constexpr int RW = 1;
    for (int base = (blockIdx.x * 8 + c.wave) * RW; base < MT; base += gridDim.x * 8 * RW) {
        f32x4 x[RW][4];
        if (base < NP) {
#pragma unroll
            for (int r = 0; r < RW; ++r)
#pragma unroll
                for (int k = 0; k < 4; ++k) { const u32x2 w = __builtin_nontemporal_load((const u32x2*)(TB + (size_t)(base + r) * 1024 + 256 * k + 4 * lane)); const f32x2v lo = unpkh(w.x), hi = unpkh(w.y); x[r][k] = (f32x4){lo.x, lo.y, hi.x, hi.y}; }
        } else {
#pragma unroll
            for (int r = 0; r < RW; ++r)
#pragma unroll
                for (int k = 0; k < 4; ++k) x[r][k] = *(const f32x4*)(XF + (size_t)(base + r) * 1024 + 256 * k + 4 * lane);
        }
        if (base >= NP) {
            const float* PART = (const float*)(c.ws + WS_PS32);
            for (int s = 0; s < nsplit; ++s)
#pragma unroll
                for (int r = 0; r < RW; ++r)
#pragma unroll
                    for (int k = 0; k < 4; ++k) x[r][k] += *(const f32x4*)(PART + ((size_t)s * 256 + (base - NP + r)) * 1024 + 256 * k + 4 * lane);
        }
#pragma unroll
        for (int r = 0; r < RW; ++r) {
            const int row = base + r; float* xr = XF + (size_t)row * 1024;
            float s = 0.f;
#pragma unroll
            for (int k = 0; k < 4; ++k) s += x[r][k][0] + x[r][k][1] + x[r][k][2] + x[r][k][3];
            const float mu = wsum(s) * (1.0f / 1024.0f);
            float v = 0.f;
#pragma unroll
            for (int k = 0; k < 4; ++k) { x[r][k] -= mu; v += x[r][k][0] * x[r][k][0] + x[r][k][1] * x[r][k][1] + x[r][k][2] * x[r][k][2] + x[r][k][3] * x[r][k][3]; }
            const float rs = rsqrtf(wsum(v) * (1.0f / 1024.0f) + EPS);
#pragma unroll
            for (int k = 0; k < 4; ++k) x[r][k] = x[r][k] * rs * gg[k] + bb[k];
            if (!final) {
#pragma unroll
                for (int k = 0; k < 4; ++k) { u32x2 o; o.x = pk2(x[r][k][0], x[r][k][1]); o.y = pk2(x[r][k][2], x[r][k][3]); *(u32x2*)(XB + (size_t)row * 1024 + 256 * k + 4 * lane) = o;
                    if (row >= NP) { const f32x4 pb = preb ? *(const f32x4*)(preb + 256 * k + 4 * lane) : (f32x4){0.f, 0.f, 0.f, 0.f};
                        *(f32x4*)(xr + 256 * k + 4 * lane) = (f32x4){bflo(o.x), bfhi(o.x), bflo(o.y), bfhi(o.y)} * ALPHA + pb; } }
            } else if (row < NP + NS) {
                float* op = row < NP ? c.out + O_YP + (size_t)row * 1024 : c.out + O_YS + (size_t)(row - NP) * 1024;
#pragma unroll
                for (int k = 0; k < 4; ++k) __builtin_nontemporal_store(x[r][k], (f32x4*)(op + 256 * k + 4 * lane));
            }
        }
    }
}

__global__ void __launch_bounds__(512) fwd_mega(Params p) {
    extern __shared__ __attribute__((aligned(16))) unsigned char smem[];
    Ctx c;
#pragma unroll
    for (int i = 0; i < 24; ++i) c.in[i] = p.in[i];
    c.out = p.out; c.ws = p.ws;
    c.tid = threadIdx.x; c.lane = c.tid & 63; c.wave = __builtin_amdgcn_readfirstlane(c.tid >> 6);
    c.lds = (LAS unsigned char*)smem; c.sm = (float*)smem;
#define RL() do { int t_ = threadIdx.x; asm volatile("" : "+v"(t_)); c.tid = t_; c.lane = t_ & 63; c.wave = __builtin_amdgcn_readfirstlane(t_ >> 6); } while (0)
    const bf16_t* XB = (const bf16_t*)(c.ws + WS_XB);
    if (threadIdx.x < 4) ((LAS unsigned*)(smem + 131072))[threadIdx.x] = 0u;
    __syncthreads();
    const XcdBarrier xbar = xcd_barrier_post((unsigned*)(c.ws + WS_BAR), (volatile LAS unsigned*)(smem + 131072));
#ifndef NO_PREP
    RL(); phase_prep(c);
#endif
    cg::this_grid().sync();
    for (int l = 0; l < DEPTH; ++l) {
#if !defined(PHM) || (PHM & 1)
        { EpiBf16 E{(bf16_t*)(c.ws + WS_P), 2048}; run_gemm(c, XB, (const bf16_t*)(c.ws + WS_W1T + l * SZ_W1T), NP, 2048, 1024, E); }
        __syncthreads();
        { EpiPart E{(float*)(c.ws + WS_PS32), 2048, NP, (size_t)256 * 2048}; run_gemm_split(c, XB, (const bf16_t*)(c.ws + WS_W1T + l * SZ_W1T), NP / 256, 2048, 1024, 256, E); }
        if (l > 0) { RL(); cache_convert(c, l, 32, 3, 4); }
#endif
        xcd_barrier(xbar);
#ifndef NO_POST1
        RL(); phase_post1(c, l);
#endif
        xcd_barrier(xbar);
#if !defined(PHM) || (PHM & 2)
        { EpiQ E{(bf16_t*)(c.ws + WS_Q), (const float*)(c.ws + WS_TAB)}; run_gemm(c, (const bf16_t*)(c.ws + WS_CQN), (const bf16_t*)(c.ws + WS_WUQT + l * SZ_WUQT), MT, 768, 384, E); }
#endif
        __syncthreads();
#if !defined(PHM) || (PHM & 4)
        { EpiBf16 E{(bf16_t*)(c.ws + WS_P), 1024}; run_gemm(c, (const bf16_t*)(c.ws + WS_CKVK), (const bf16_t*)(c.ws + WS_WKVT + l * SZ_WKVT), KR, 1024, 256, E, 0, true); }
#endif
        xcd_barrier(xbar);
#ifndef NO_ATTN
        RL(); phase_attn(c, l);
#endif
        xcd_barrier(xbar);
#ifndef NO_POST2
        RL(); phase_post2(c, l);
#endif
        xcd_barrier(xbar);
#if !defined(PHM) || (PHM & 8)
        { EpiRes E{(bf16_t*)(c.ws + WS_XF), XB, nullptr}; run_gemm(c, (const bf16_t*)(c.ws + WS_Y), (const bf16_t*)(c.ws + WS_WOUTT + l * SZ_WOUTT), NP, 1024, 1024, E); }
        __syncthreads();
        { EpiPart E{(float*)(c.ws + WS_PS32), 1024, NP, (size_t)256 * 1024}; run_gemm_split(c, (const bf16_t*)(c.ws + WS_Y), (const bf16_t*)(c.ws + WS_WOUTT + l * SZ_WOUTT), NP / 256, 1024, 1024, 256, E); }
        if (l + 1 < DEPTH) { RL(); cache_convert(c, l + 1, 16, 0, 4); }
#endif
        xcd_barrier(xbar);
#if !defined(PHM) || (PHM & 64)
        RL(); phase_ln(c, c.in[16] + l * 1024, c.in[17] + l * 1024, c.in[21] + l * 1024, false, 4);
#endif
        xcd_barrier(xbar);
#if !defined(PHM) || (PHM & 16)
        { EpiRelu2 E{(bf16_t*)(c.ws + WS_H), HLD, c.in[19] + l * 4096}; run_gemm(c, XB, (const bf16_t*)(c.ws + WS_WUPT + l * SZ_WUPT), MT, 4096, 1024, E); }
        if (l + 1 < DEPTH) { RL(); cache_convert(c, l + 1, 16, 1, 4); }
#endif
        xcd_barrier(xbar);
#if !defined(PHM) || (PHM & 32)
        { EpiRes E{(bf16_t*)(c.ws + WS_XF), XB, c.in[21] + l * 1024}; run_gemm(c, (const bf16_t*)(c.ws + WS_H), (const bf16_t*)(c.ws + WS_WDNT + l * SZ_WDNT), NP, 1024, 4096, E, HLD); }
        __syncthreads();
        { EpiPart E{(float*)(c.ws + WS_PS32), 1024, NP, (size_t)256 * 1024}; run_gemm_split(c, (const bf16_t*)(c.ws + WS_H), (const bf16_t*)(c.ws + WS_WDNT + l * SZ_WDNT), NP / 256, 1024, 4096, 512, E, HLD); }
        if (l + 1 < DEPTH) { RL(); cache_convert(c, l + 1, 32, 2, 4); }
#endif
        xcd_barrier(xbar);
#if !defined(PHM) || (PHM & 64)
        RL(); phase_ln(c, c.in[22] + l * 1024, c.in[23] + l * 1024, nullptr, l == DEPTH - 1, 8);
#endif
        if (l + 1 < DEPTH) xcd_barrier(xbar);
    }
}

constexpr int LDS_BYTES = 131072 + 16;
extern "C" void kernel_launch(void* const* d_in, const int* in_sizes, int n_in, void* d_out, int out_size, void* d_ws, size_t ws_size, hipStream_t stream) {
    static int grid = 0;
    if (grid == 0) {
        if (n_in != 24 || ws_size < WS_END) { fprintf(stderr, "kernel_launch: n_in %d ws %zu need %zu\n", n_in, ws_size, (size_t)WS_END); grid = -1; return; }
        int dev = 0, cus = 0, per_cu = 0;
        hipGetDevice(&dev); hipDeviceGetAttribute(&cus, hipDeviceAttributeMultiprocessorCount, dev);
        hipFuncSetAttribute((const void*)fwd_mega, hipFuncAttributeMaxDynamicSharedMemorySize, LDS_BYTES);
        hipOccupancyMaxActiveBlocksPerMultiprocessor(&per_cu, (const void*)fwd_mega, 512, LDS_BYTES);
        if (per_cu < 1) per_cu = 1;
        grid = cus * per_cu; if (grid > 256) grid = 256;
        (void)hipGetLastError();
    }
    if (grid < 0) return;
    if (hipMemsetAsync((char*)d_ws + WS_BAR, 0, 16384, stream) != hipSuccess) { fprintf(stderr, "memset failed\n"); return; }
    Params p{};
    for (int i = 0; i < 24; ++i) p.in[i] = (const float*)d_in[i];
    p.out = (float*)d_out; p.ws = (unsigned char*)d_ws;
    void* args[] = {&p};
    hipError_t e = hipLaunchCooperativeKernel((const void*)fwd_mega, dim3(grid), dim3(512), args, LDS_BYTES, stream);
    if (e != hipSuccess) fprintf(stderr, "cooperative launch failed: %s (grid %d)\n", hipGetErrorString(e), grid);
}
```
